# Optimizing an MI355X kernel written in HIP

```python
import math
import jax, jax.numpy as jnp
from jax import lax
import numpy as np

D_MODEL = 2048
BATCH = 4
SEQ = 4096
DEPTH = 2

HEAD_DIM = 128
N_ATTN_HEADS = D_MODEL // (2 * HEAD_DIM)
N_CONV_GROUPS = D_MODEL // (2 * HEAD_DIM)
D_ATTN = N_ATTN_HEADS * HEAD_DIM
D_CONV = N_CONV_GROUPS * HEAD_DIM
D_MIX = D_ATTN + D_CONV
D_IN = 3 * D_ATTN + 3 * D_CONV
SPLIT_POINTS = (D_ATTN, 2 * D_ATTN, 3 * D_ATTN, 3 * D_ATTN + D_CONV, 3 * D_ATTN + 2 * D_CONV)
D_FF = 4 * D_MODEL
CONV_WIDTH = 3
DILATED_CONFIGS = ((128, 1), (512, 4), (2048, 16))
BAND_BLOCK = 128
ROPE_THETA = 10000.0
DEEPNORM_ALPHA = (2 * DEPTH) ** 0.25
DEEPNORM_BETA = (8 * DEPTH) ** -0.25
MOD_SCALE = 0.1
LN_EPS = 1e-5
RMS_EPS = 1e-6
NEG_INF = -1e30

kernel_name = "hymba_dilated_attn_shortconv_deepnorm_adaln"


def _layer_norm(x, g, b):
    xf = x.astype(jnp.float32)
    mu = jnp.mean(xf, axis=-1, keepdims=True)
    var = jnp.mean(jnp.square(xf - mu), axis=-1, keepdims=True)
    y = (xf - mu) * lax.rsqrt(var + LN_EPS) * g.astype(jnp.float32) + b.astype(jnp.float32)
    return y.astype(x.dtype)


def _group_rms_norm(x, g):
    b, s, d = x.shape
    xf = x.astype(jnp.float32).reshape(b, s, d // HEAD_DIM, HEAD_DIM)
    xf = xf * lax.rsqrt(jnp.mean(jnp.square(xf), axis=-1, keepdims=True) + RMS_EPS)
    return (xf.reshape(b, s, d) * g.astype(jnp.float32)).astype(x.dtype)


def _rotary(t):
    s, dh = t.shape[2], t.shape[3]
    inv_freq = ROPE_THETA ** (-jnp.arange(0, dh, 2, dtype=jnp.float32) / dh)
    ang = jnp.arange(s, dtype=jnp.float32)[:, None] * inv_freq[None, :]
    cos = jnp.concatenate([jnp.cos(ang), jnp.cos(ang)], axis=-1)
    sin = jnp.concatenate([jnp.sin(ang), jnp.sin(ang)], axis=-1)
    tf = t.astype(jnp.float32)
    t1, t2 = jnp.split(tf, 2, axis=-1)
    rot = jnp.concatenate([-t2, t1], axis=-1)
    return (tf * cos + rot * sin).astype(t.dtype)


def _dilated_branch(q, k, v, window, dilation):
    b, h, s, dh = q.shape
    span = window // dilation
    seg = s // dilation
    nblk = -(-seg // BAND_BLOCK)
    pad = nblk * BAND_BLOCK - seg

    def to_blocks(t):
        t = t.reshape(b, h, seg, dilation, dh).transpose(0, 1, 3, 2, 4)
        t = jnp.pad(t, ((0, 0), (0, 0), (0, 0), (0, pad), (0, 0)))
        return t.reshape(b, h, dilation, nblk, BAND_BLOCK, dh)

    def with_prev(t):
        prev = jnp.pad(t[:, :, :, :-1], ((0, 0), (0, 0), (0, 0), (1, 0), (0, 0), (0, 0)))
        return jnp.concatenate([prev, t], axis=4)

    qb = to_blocks(q)
    kk = with_prev(to_blocks(k))
    vv = with_prev(to_blocks(v))
    scores = jnp.einsum('bhrnqd,bhrnkd->bhrnqk', qb, kk,
                        preferred_element_type=jnp.float32) * (dh ** -0.5)
    qi = jnp.arange(BAND_BLOCK)[:, None]
    kj = jnp.arange(2 * BAND_BLOCK)[None, :]
    dist = BAND_BLOCK + qi - kj
    band = (dist >= 0) & (dist <= span)
    has_prev = (jnp.arange(nblk)[:, None, None] > 0) | (kj[None] >= BAND_BLOCK)
    valid = band[None] & has_prev
    scores = jnp.where(valid, scores, NEG_INF)
    lse = jax.nn.logsumexp(scores, axis=-1)
    probs = jnp.exp(scores - lse[..., None])
    out = jnp.einsum('bhrnqk,bhrnkd->bhrnqd', probs, vv.astype(jnp.float32))
    out = out.reshape(b, h, dilation, nblk * BAND_BLOCK, dh)[:, :, :, :seg]
    out = out.transpose(0, 1, 3, 2, 4).reshape(b, h, s, dh)
    lse = lse.reshape(b, h, dilation, nblk * BAND_BLOCK)[..., :seg]
    lse = lse.transpose(0, 1, 3, 2).reshape(b, h, s)
    return out, lse


def _dilated_mixture(q, k, v):
    outs, lses = [], []
    for window, dilation in DILATED_CONFIGS:
        o, l = _dilated_branch(q, k, v, window, dilation)
        outs.append(o)
        lses.append(l)
    weights = jax.nn.softmax(jnp.stack(lses, axis=0), axis=0)
    return jnp.sum(weights[..., None] * jnp.stack(outs, axis=0), axis=0)


def _causal_short_conv(h, w):
    s = h.shape[1]
    hp = jnp.pad(h, ((0, 0), (CONV_WIDTH - 1, 0), (0, 0)))
    return sum(w[i] * hp[:, i:i + s] for i in range(CONV_WIDTH))


def setup_inputs(seed: int = 0) -> dict:
    key = jax.random.key(seed)
    ks = jax.random.split(key, 16)
    f32 = jnp.float32
    col_scale = jnp.ones((D_IN,), f32).at[2 * D_ATTN:3 * D_ATTN].set(DEEPNORM_BETA)
    return {
        "x": jax.random.normal(ks[0], (BATCH, SEQ, D_MODEL), f32),
        "c": jax.random.normal(ks[1], (BATCH, D_MODEL), f32),
        "w_in": jax.random.normal(ks[2], (DEPTH, D_MODEL, D_IN), f32) * (D_MODEL ** -0.5) * col_scale,
        "conv_w": jax.random.normal(ks[3], (DEPTH, CONV_WIDTH, D_CONV), f32) * (CONV_WIDTH ** -0.5),
        "mix_norm_g": 1.0 + 0.02 * jax.random.normal(ks[4], (DEPTH, D_MIX), f32),
        "w_out": jax.random.normal(ks[5], (DEPTH, D_MIX, D_MODEL), f32) * (D_MIX ** -0.5) * DEEPNORM_BETA,
        "w_mod": jax.random.normal(ks[6], (DEPTH, D_MODEL, 6 * D_MODEL), f32) * (D_MODEL ** -0.5) * MOD_SCALE,
        "b_mod": 0.01 * jax.random.normal(ks[7], (DEPTH, 6 * D_MODEL), f32),
        "ln1_g": 1.0 + 0.02 * jax.random.normal(ks[8], (DEPTH, D_MODEL), f32),
        "ln1_b": 0.01 * jax.random.normal(ks[9], (DEPTH, D_MODEL), f32),
        "w_ff1": jax.random.normal(ks[10], (DEPTH, D_MODEL, D_FF), f32) * (D_MODEL ** -0.5) * DEEPNORM_BETA,
        "w_ff2": jax.random.normal(ks[11], (DEPTH, D_FF, D_MODEL), f32) * (D_FF ** -0.5) * DEEPNORM_BETA,
        "ln2_g": 1.0 + 0.02 * jax.random.normal(ks[12], (DEPTH, D_MODEL), f32),
        "ln2_b": 0.01 * jax.random.normal(ks[13], (DEPTH, D_MODEL), f32),
    }


def reference(x, c, w_in, conv_w, mix_norm_g, w_out, w_mod, b_mod,
              ln1_g, ln1_b, w_ff1, w_ff2, ln2_g, ln2_b):
    b, s, _ = x.shape
    cond = jax.nn.silu(c)

    def heads(t):
        return t.reshape(b, s, N_ATTN_HEADS, HEAD_DIM).transpose(0, 2, 1, 3)

    for l in range(DEPTH):
        mod = cond @ w_mod[l] + b_mod[l]
        sh1, sc1, g1, sh2, sc2, g2 = jnp.split(mod[:, None, :], 6, axis=-1)

        u = x * (1.0 + sc1) + sh1
        proj = u @ w_in[l]
        q, k, v, gate_b, gate_c, h_in = jnp.split(proj, SPLIT_POINTS, axis=-1)
        attn = _dilated_mixture(_rotary(heads(q)), _rotary(heads(k)), heads(v))
        attn = attn.transpose(0, 2, 1, 3).reshape(b, s, D_ATTN).astype(x.dtype)
        conv = gate_b * _causal_short_conv(gate_c * h_in, conv_w[l])
        mixed = _group_rms_norm(jnp.concatenate([attn, conv], axis=-1), mix_norm_g[l])
        x = _layer_norm(DEEPNORM_ALPHA * x + (1.0 + g1) * (mixed @ w_out[l]), ln1_g[l], ln1_b[l])

        u = x * (1.0 + sc2) + sh2
        ff = jnp.square(jax.nn.relu(u @ w_ff1[l])) @ w_ff2[l]
        x = _layer_norm(DEEPNORM_ALPHA * x + (1.0 + g2) * ff, ln2_g[l], ln2_b[l])
    return x
```

```cpp
#include <hip/hip_runtime.h>
#include <hip/hip_cooperative_groups.h>
#include <cstdio>
namespace cg = cooperative_groups;

#ifndef SINGLE_LAUNCH
#define SINGLE_LAUNCH 1
#endif

#define LAS __attribute__((address_space(3)))
typedef unsigned short bf16_t;
typedef short bf16x8 __attribute__((ext_vector_type(8)));
typedef short s16x4 __attribute__((ext_vector_type(4)));
typedef float f32x4 __attribute__((ext_vector_type(4)));
typedef float f32x2 __attribute__((ext_vector_type(2)));
typedef unsigned u32x4 __attribute__((ext_vector_type(4)));
typedef unsigned u32x2 __attribute__((ext_vector_type(2)));

constexpr int T_TOK = 16384, SEQ = 4096, DM = 2048, DIN = 6144, DFF = 8192, NLAYER = 2;
constexpr int KPAD = 0, LDU = DM + KPAD, LDH = DFF + KPAD;
constexpr float ALPHA = 1.4142135623730951f;
constexpr float QSCALE = 0.08838834764831845f * 1.4426950408889634f;

constexpr size_t WS_WT_IN = 0;
constexpr size_t WS_WT_OUT = WS_WT_IN + (size_t)NLAYER * DIN * LDU * 2;
constexpr size_t WS_WT_FF1 = WS_WT_OUT + (size_t)NLAYER * DM * LDU * 2;
constexpr size_t WS_WT_FF2 = WS_WT_FF1 + (size_t)NLAYER * DFF * LDU * 2;
constexpr size_t WS_MOD = WS_WT_FF2 + (size_t)NLAYER * DM * LDH * 2;
constexpr size_t WS_COS = WS_MOD + (size_t)NLAYER * 4 * 6 * DM * 4;
constexpr size_t WS_SIN = WS_COS + (size_t)SEQ * 64 * 4;
constexpr size_t WS_U = WS_SIN + (size_t)SEQ * 64 * 4;
constexpr size_t WS_PROJ = WS_U + (size_t)T_TOK * LDU * 2;
constexpr size_t WS_OPART = WS_PROJ + (size_t)T_TOK * DIN * 2;
constexpr size_t WS_LSE = WS_OPART + (size_t)3 * T_TOK * 1024 * 4;
constexpr size_t WS_CTL = WS_LSE + (size_t)3 * T_TOK * 8 * 4;
constexpr size_t WS_STATS = WS_CTL + 20480;
constexpr size_t WS_END = WS_STATS + (size_t)T_TOK * 2 * 4;
constexpr size_t WS_ZB = WS_OPART + (size_t)2 * T_TOK * 1024 * 2;
constexpr size_t WS_H = WS_PROJ;

constexpr int LDS_ST = 256 * 272 + 256 * 288;
constexpr int LDS_BYTES = LDS_ST + 16;

struct Params {
    const float* x; const float* c; const float* w_in; const float* conv_w; const float* mix_g; const float* w_out;
    const float* w_mod; const float* b_mod; const float* ln1_g; const float* ln1_b; const float* w_ff1; const float* w_ff2;
    const float* ln2_g; const float* ln2_b;
    float* out; unsigned char* ws;
    int ph_lo, ph_hi, never, pad;
};

__device__ __forceinline__ unsigned cvt_pk_bf16(float lo, float hi) { unsigned r; asm volatile("v_cvt_pk_bf16_f32 %0, %1, %2" : "=v"(r) : "v"(lo), "v"(hi)); return r; }
__device__ __forceinline__ int opaque_tid() { int t = threadIdx.x; asm volatile("" : "+v"(t)); return t; }
__device__ __forceinline__ float bf2f(unsigned short b) { return __uint_as_float(((unsigned)b) << 16); }
__device__ __forceinline__ float bflo(unsigned w) { return __uint_as_float(w << 16); }
__device__ __forceinline__ float bfhi(unsigned w) { return __uint_as_float(w & 0xffff0000u); }

namespace pg8 {
constexpr int BM = 256, BK = 64, HALF = 128, HTB = HALF * BK * 2, STAGE_BYTES = 8 * HTB, NXCD = 8, WGM = 8;
__device__ __forceinline__ int lds_byte(int r, int c) { const int st = (r >> 4) * 2 + (c >> 5), rr = r & 15, cc = c & 31, ob = rr * 64 + cc * 2; return st * 1024 + (ob ^ (((ob >> 9) & 1) << 5)); }
__device__ __forceinline__ void stage_rc(int b, int& R, int& C) { const int st = b / 1024, sb = b % 1024, swz = sb ^ (((sb >> 9) & 1) << 5); R = (st >> 1) * 16 + swz / 64; C = (st & 1) * 32 + (swz % 64) / 2; }
__device__ __forceinline__ int perm32(int rho) { const int n = rho >> 4, i = rho & 15; return 8 * (i >> 2) + 4 * n + (i & 3); }
__device__ __forceinline__ int bperm(int mode, int R) {
    if (mode == 1) return (R & ~31) + perm32(R & 31);
    if (mode == 2) return 64 * ((R >> 4) & 1) + 16 * (R >> 5) + (R & 15);
    return R;
}
__device__ __forceinline__ int bperm_inv(int mode, int s) {
    if (mode == 1) { const int t = s & 31; return (s & ~31) + 16 * ((t >> 2) & 1) + 4 * (t >> 3) + (t & 3); }
    if (mode == 2) return 32 * ((s >> 4) & 3) + 16 * (s >> 6) + (s & 15);
    return s;
}
__device__ __forceinline__ size_t tiled_off(int row, int k, int nkt) {
    return ((size_t)((row >> 7) * nkt + (k >> 6)) << 13) + (size_t)(lds_byte(row & 127, k & 63) >> 1);
}
struct Unit { int pm, pn; };
struct Gemm { const bf16_t* A; const bf16_t* Bt; int M, N, K, lda, ldb; };
struct StaticOrder {
    int nM, nN, nwg, G, c;
    __device__ void init(int M, int N, int G_, int c_) { nM = M / BM; nN = N / BM; nwg = nM * nN; G = G_; c = c_; }
    __device__ bool next(int i, Unit& u) const {
        const long L = (long)i * G + c; if (L >= nwg) return false;
        int wgid = (int)L; { const int q = nwg / NXCD, r = nwg % NXCD, xcd = wgid % NXCD, off = wgid / NXCD; wgid = (xcd < r ? xcd * (q + 1) : r * (q + 1) + (xcd - r) * q) + off; }
        const int nig = WGM * nN, gid = wgid / nig, fm = gid * WGM, gsz = (nM - fm) < WGM ? (nM - fm) : WGM;
        u.pm = fm + ((wgid % nig) % gsz); u.pn = (wgid % nig) / gsz; return true;
    }
};

template <class Epi>
__device__ __forceinline__ void gemm_phase(LAS unsigned char* lds, const Gemm g, const StaticOrder& S, const Epi& E) {
    const int tid = opaque_tid(), wid = __builtin_amdgcn_readfirstlane(tid >> 6), lane = tid & 63, wr = wid >> 2, wc = wid & 3, fr = lane & 15, fq = lane >> 4;
    const int K = g.K, nt = K / BK;
    unsigned voffA[2], voffB[2];
#pragma unroll
    for (int i = 0; i < 2; ++i) { voffA[i] = (unsigned)(tid * 16 + i * 8192); voffB[i] = voffA[i]; }
    const size_t kstep = (size_t)HTB;
    const size_t hstepA = (size_t)nt * HTB, hstepB = hstepA;
    const size_t tstepA = 2 * hstepA, tstepB = tstepA;
    const unsigned ldsw = (unsigned)wid * 1024u;
    const int aoff = lds_byte(wr * 64 + fr, fq * 8), boff = lds_byte(wc * 32 + fr, fq * 8);
#define PG8_SA(b, h) (((b) * 2 + (h)) * HTB)
#define PG8_SB(b, h) ((4 + (b) * 2 + (h)) * HTB)
#define PG8_STAGE(bufoff, gbase, voff) do { _Pragma("unroll") for (int _i = 0; _i < 2; ++_i) \
        __builtin_amdgcn_global_load_lds((const unsigned*)((const char*)(gbase) + (voff)[_i]), (LAS unsigned*)(lds + (bufoff) + ldsw + _i * 8192), 16, 0, 0); } while (0)
#define PG8_LDA(dst, b, h) do { _Pragma("unroll") for (int m = 0; m < 4; ++m) _Pragma("unroll") for (int k = 0; k < 2; ++k) dst[m][k] = *(const LAS bf16x8*)(lds + PG8_SA(b, h) + aoff + m * 2048 + k * 1024); } while (0)
#define PG8_LDB(dst, b, h) do { _Pragma("unroll") for (int n = 0; n < 2; ++n) _Pragma("unroll") for (int k = 0; k < 2; ++k) dst[n][k] = *(const LAS bf16x8*)(lds + PG8_SB(b, h) + boff + n * 2048 + k * 1024); } while (0)
#define PG8_MMA(ai, bj, At, Bt) do { __builtin_amdgcn_s_setprio(1); _Pragma("unroll") for (int m = 0; m < 4; ++m) _Pragma("unroll") for (int n = 0; n < 2; ++n) _Pragma("unroll") for (int k = 0; k < 2; ++k) \
        acc[ai][bj][m][n] = __builtin_amdgcn_mfma_f32_16x16x32_bf16(Bt[n][k], At[m][k], acc[ai][bj][m][n], 0, 0, 0); __builtin_amdgcn_s_setprio(0); } while (0)
#define PG8_WAIT_V(n) asm volatile("s_waitcnt vmcnt(" #n ")" ::: "memory")
#define PG8_WAIT_L(n) asm volatile("s_waitcnt lgkmcnt(" #n ")" ::: "memory")
#define PG8_BAR __builtin_amdgcn_s_barrier()
#define PG8_SCHED __builtin_amdgcn_sched_barrier(0)
    Unit cur, nxt; int ui = 0;
    if (!S.next(0, cur)) return;
    f32x4 acc[2][2][4][2];
#pragma unroll
    for (int a = 0; a < 2; ++a)
#pragma unroll
        for (int b = 0; b < 2; ++b)
#pragma unroll
            for (int m = 0; m < 4; ++m)
#pragma unroll
                for (int n = 0; n < 2; ++n) acc[a][b][m][n] = (f32x4){0.f, 0.f, 0.f, 0.f};
    bf16x8 At[4][2], B0[2][2], B1[2][2];
    const char* cA = (const char*)g.A + (size_t)cur.pm * tstepA; const char* cB = (const char*)g.Bt + (size_t)cur.pn * tstepB;
    PG8_STAGE(PG8_SB(0, 0), cB, voffB); PG8_STAGE(PG8_SA(0, 0), cA, voffA); PG8_STAGE(PG8_SB(0, 1), cB + hstepB, voffB); PG8_STAGE(PG8_SA(0, 1), cA + hstepA, voffA);
    if (wr == 1) PG8_BAR;
    PG8_WAIT_V(4); PG8_BAR;
    PG8_STAGE(PG8_SB(1, 0), cB + kstep, voffB); PG8_STAGE(PG8_SA(1, 0), cA + kstep, voffA); PG8_STAGE(PG8_SB(1, 1), cB + hstepB + kstep, voffB);
    PG8_WAIT_V(6); PG8_BAR;
    for (;;) {
        const bool has_next = S.next(ui + 1, nxt);
        const char* nA = has_next ? (const char*)g.A + (size_t)nxt.pm * tstepA : cA; const char* nB = has_next ? (const char*)g.Bt + (size_t)nxt.pn * tstepB : cB;
        for (int t = 0; t < nt; t += 2) {
            const bool last = (t == nt - 2);
            const char* a1 = cA + (size_t)(t + 1) * kstep;
            const char* a2 = last ? nA : cA + (size_t)(t + 2) * kstep; const char* b2 = last ? nB : cB + (size_t)(t + 2) * kstep;
            const char* a3 = a2 + kstep; const char* b3 = b2 + kstep;
            PG8_LDB(B0, 0, 0); PG8_SCHED; PG8_LDA(At, 0, 0); PG8_STAGE(PG8_SA(1, 1), a1 + hstepA, voffA);
            PG8_WAIT_L(8); PG8_BAR; PG8_WAIT_L(0); PG8_MMA(0, 0, At, B0); PG8_BAR; PG8_SCHED;
            PG8_LDB(B1, 0, 1); PG8_STAGE(PG8_SB(0, 0), b2, voffB);
            PG8_BAR; PG8_WAIT_L(0); PG8_MMA(0, 1, At, B1); PG8_BAR;
            PG8_LDA(At, 0, 1); PG8_STAGE(PG8_SA(0, 0), a2, voffA);
            PG8_BAR; PG8_WAIT_L(0); PG8_MMA(1, 0, At, B0); PG8_BAR; PG8_SCHED;
            PG8_STAGE(PG8_SB(0, 1), b2 + hstepB, voffB);
            PG8_WAIT_V(6); PG8_BAR; PG8_MMA(1, 1, At, B1); PG8_BAR;
            PG8_LDB(B0, 1, 0); PG8_SCHED; PG8_LDA(At, 1, 0); PG8_STAGE(PG8_SA(0, 1), a2 + hstepA, voffA);
            PG8_WAIT_L(8); PG8_BAR; PG8_WAIT_L(0); PG8_MMA(0, 0, At, B0); PG8_BAR; PG8_SCHED;
            PG8_LDB(B1, 1, 1); PG8_STAGE(PG8_SB(1, 0), b3, voffB);
            PG8_BAR; PG8_WAIT_L(0); PG8_MMA(0, 1, At, B1); PG8_BAR;
            PG8_LDA(At, 1, 1); PG8_STAGE(PG8_SA(1, 0), a3, voffA);
            PG8_BAR; PG8_WAIT_L(0); PG8_MMA(1, 0, At, B0); PG8_BAR; PG8_SCHED;
            PG8_STAGE(PG8_SB(1, 1), b3 + hstepB, voffB);
            PG8_WAIT_V(6); PG8_BAR; PG8_MMA(1, 1, At, B1); PG8_BAR;
        }
        E(acc, cur, wr, wc, fr, fq);
        if (!has_next) break;
#pragma unroll
        for (int a = 0; a < 2; ++a)
#pragma unroll
            for (int b = 0; b < 2; ++b)
#pragma unroll
                for (int m = 0; m < 4; ++m)
#pragma unroll
                    for (int n = 0; n < 2; ++n) acc[a][b][m][n] = (f32x4){0.f, 0.f, 0.f, 0.f};
        cur = nxt; cA = nA; cB = nB; ++ui;
    }
    PG8_WAIT_V(0);
    if (wr == 0) PG8_BAR;
    PG8_BAR;
#undef PG8_SA
#undef PG8_SB
#undef PG8_STAGE
#undef PG8_LDA
#undef PG8_LDB
#undef PG8_MMA
#undef PG8_WAIT_V
#undef PG8_WAIT_L
#undef PG8_BAR
#undef PG8_SCHED
}

struct EpiProj {
    static constexpr int PERM = 2;
    bf16_t* O; const float* cosT; const float* sinT;
    __device__ __forceinline__ void operator()(const f32x4 (&acc)[2][2][4][2], const Unit& u, int wr, int wc, int fr, int fq) const {
        const int row0 = u.pm * BM + wr * 64 + fr, j0 = wc * 16 + 4 * fq, colb = u.pn * BM + j0;
        if (u.pn < 8) {
            const float sc = (u.pn < 4) ? QSCALE : 1.0f;
#pragma unroll
            for (int ai = 0; ai < 2; ++ai) {
                f32x4 csv[4], snv[4];
#pragma unroll
                for (int m = 0; m < 4; ++m) { const int pos = (row0 + ai * HALF + m * 16) & (SEQ - 1); csv[m] = *(const f32x4*)(cosT + pos * 64 + j0); snv[m] = *(const f32x4*)(sinT + pos * 64 + j0); }
#pragma unroll
                for (int m = 0; m < 4; ++m) {
                    const int row = row0 + ai * HALF + m * 16;
                    const f32x4 cs = csv[m], sn = snv[m];
                    bf16_t* rowp = O + (size_t)row * DIN + colb;
#pragma unroll
                    for (int bj = 0; bj < 2; ++bj) {
                        const f32x4 a = acc[ai][bj][m][0], b = acc[ai][bj][m][1];
                        const f32x4 o1 = (a * cs - b * sn) * sc, o2 = (b * cs + a * sn) * sc;
                        u32x2 w1, w2; w1.x = cvt_pk_bf16(o1[0], o1[1]); w1.y = cvt_pk_bf16(o1[2], o1[3]); w2.x = cvt_pk_bf16(o2[0], o2[1]); w2.y = cvt_pk_bf16(o2[2], o2[3]);
                        *(u32x2*)(rowp + bj * HALF) = w1; *(u32x2*)(rowp + bj * HALF + 64) = w2;
                    }
                }
            }
        } else {
#pragma unroll
            for (int ai = 0; ai < 2; ++ai)
#pragma unroll
                for (int m = 0; m < 4; ++m) {
                    const int row = row0 + ai * HALF + m * 16;
                    bf16_t* rowp = O + (size_t)row * DIN + colb;
#pragma unroll
                    for (int bj = 0; bj < 2; ++bj) {
                        const f32x4 o1 = acc[ai][bj][m][0], o2 = acc[ai][bj][m][1];
                        u32x2 w1, w2; w1.x = cvt_pk_bf16(o1[0], o1[1]); w1.y = cvt_pk_bf16(o1[2], o1[3]); w2.x = cvt_pk_bf16(o2[0], o2[1]); w2.y = cvt_pk_bf16(o2[2], o2[3]);
                        *(u32x2*)(rowp + bj * HALF) = w1; *(u32x2*)(rowp + bj * HALF + 64) = w2;
                    }
                }
        }
    }
};
struct EpiRes {
    static constexpr int PERM = 1;
    bf16_t* z; const float* gate;
    const float* stats; const float* lng; const float* lnb;
    __device__ __forceinline__ void operator()(const f32x4 (&acc)[2][2][4][2], const Unit& u, int wr, int wc, int fr, int fq) const {
        const int row0 = u.pm * BM + wr * 64 + fr, col0 = u.pn * BM + wc * 32 + 8 * fq;
        const float* gb = gate + (size_t)(row0 >> 12) * (6 * DM);
        const bool ln = stats != nullptr;
        constexpr int GB[4] = {0, 4, 8, 16};
        f32x2 st[4];
#pragma unroll
        for (int grp = 0; grp < 3; ++grp) {
            u32x4 xv[8]; f32x4 cg[2][2], cl[2][2], cb[2][2];
            if (grp == 0 || grp == 2) {
#pragma unroll
                for (int m = 0; m < 4; ++m) st[m] = ln ? *(const f32x2*)(stats + 2 * (row0 + (grp ? HALF : 0) + m * 16)) : (f32x2){0.f, 1.f};
            }
#pragma unroll
            for (int j = GB[grp]; j < GB[grp + 1]; ++j) {
                const int k = j >> 2, m = j & 3, ai = k >> 1, col = col0 + (k & 1) * HALF, kk = k - (GB[grp] >> 2);
                if (m == 0) {
#pragma unroll
                    for (int n = 0; n < 2; ++n) { cg[kk][n] = *(const f32x4*)(gb + col + 4 * n) + 1.0f; cl[kk][n] = (f32x4){1.f, 1.f, 1.f, 1.f}; cb[kk][n] = (f32x4){0.f, 0.f, 0.f, 0.f};
                        if (ln) { cl[kk][n] = *(const f32x4*)(lng + col + 4 * n); cb[kk][n] = *(const f32x4*)(lnb + col + 4 * n); } }
                }
                xv[j - GB[grp]] = *(const u32x4*)(z + (size_t)(row0 + ai * HALF + m * 16) * DM + col);
            }
#pragma unroll
            for (int j = GB[grp]; j < GB[grp + 1]; ++j) {
                const int k = j >> 2, m = j & 3, ai = k >> 1, bj = k & 1, col = col0 + bj * HALF, kk = k - (GB[grp] >> 2);
                const u32x4 r = xv[j - GB[grp]];
                f32x4 x0 = {bflo(r.x), bfhi(r.x), bflo(r.y), bfhi(r.y)}, x1 = {bflo(r.z), bfhi(r.z), bflo(r.w), bfhi(r.w)};
                x0 = (x0 - st[m].x) * st[m].y * cl[kk][0] + cb[kk][0]; x1 = (x1 - st[m].x) * st[m].y * cl[kk][1] + cb[kk][1];
                const f32x4 o0 = x0 * ALPHA + cg[kk][0] * acc[ai][bj][m][0], o1 = x1 * ALPHA + cg[kk][1] * acc[ai][bj][m][1];
                u32x4 w; w.x = cvt_pk_bf16(o0[0], o0[1]); w.y = cvt_pk_bf16(o0[2], o0[3]); w.z = cvt_pk_bf16(o1[0], o1[1]); w.w = cvt_pk_bf16(o1[2], o1[3]);
                *(u32x4*)(z + (size_t)(row0 + ai * HALF + m * 16) * DM + col) = w;
            }
        }
    }
};
struct EpiFF1 {
    static constexpr int PERM = 1;
    bf16_t* O;
    __device__ __forceinline__ void operator()(const f32x4 (&acc)[2][2][4][2], const Unit& u, int wr, int wc, int fr, int fq) const {
        const int row0 = u.pm * BM + wr * 64 + fr, col0 = u.pn * BM + wc * 32 + 8 * fq;
#pragma unroll
        for (int ai = 0; ai < 2; ++ai)
#pragma unroll
            for (int m = 0; m < 4; ++m) {
                const int rowi = row0 + ai * HALF + m * 16;
#pragma unroll
                for (int bj = 0; bj < 2; ++bj) {
                    f32x4 v0 = acc[ai][bj][m][0], v1 = acc[ai][bj][m][1];
#pragma unroll
                    for (int j = 0; j < 4; ++j) { const float a = fmaxf(v0[j], 0.f), b = fmaxf(v1[j], 0.f); v0[j] = a * a; v1[j] = b * b; }
                    u32x4 w; w.x = cvt_pk_bf16(v0[0], v0[1]); w.y = cvt_pk_bf16(v0[2], v0[3]); w.z = cvt_pk_bf16(v1[0], v1[1]); w.w = cvt_pk_bf16(v1[2], v1[3]);
                    *(u32x4*)(O + tiled_off(rowi, col0 + bj * HALF, DFF / 64)) = w;
                }
            }
    }
};
}

__device__ __forceinline__ void pro_a_phase(const Params& p, LAS unsigned char* lds) {
    const int tid = opaque_tid();
    LAS float* cond = (LAS float*)lds;
    LAS float* red = (LAS float*)(lds + 32768);
    LAS float* tile = (LAS float*)(lds + 65536);
    float* mod = (float*)(p.ws + WS_MOD);
    const int G = gridDim.x;
    constexpr int N_GEMV = 256, N_ROPE = 512, N_TR = 12288, FIRST_TR = N_GEMV + N_ROPE;
    if ((int)blockIdx.x < N_GEMV) {
        for (int i = tid; i < 4 * DM; i += 512) { const float v = p.c[i]; cond[i] = v / (1.0f + __expf(-v)); }
        __syncthreads();
    }
    int item = blockIdx.x;
    for (; item < FIRST_TR; item += G) {
        if (item < N_GEMV) {
            const int l = item >> 7, n0 = (item & 127) * 96, cq = tid & 31, kg = tid >> 5;
            const float* wp = p.w_mod + (size_t)l * DM * (6 * DM) + (size_t)(kg * 128) * (6 * DM) + n0 + cq * 4;
            const LAS float* cp = cond + kg * 128;
            f32x4 a0 = {0.f, 0.f, 0.f, 0.f}, a1 = a0, a2 = a0, a3 = a0;
            if (cq < 24)
#pragma unroll 8
            for (int k = 0; k < 128; ++k) {
                const f32x4 w = *(const f32x4*)(wp + (size_t)k * (6 * DM));
                a0 += w * cp[k]; a1 += w * cp[DM + k]; a2 += w * cp[2 * DM + k]; a3 += w * cp[3 * DM + k];
            }
            *(LAS f32x4*)(red + (kg * 4 + 0) * 128 + cq * 4) = a0; *(LAS f32x4*)(red + (kg * 4 + 1) * 128 + cq * 4) = a1;
            *(LAS f32x4*)(red + (kg * 4 + 2) * 128 + cq * 4) = a2; *(LAS f32x4*)(red + (kg * 4 + 3) * 128 + cq * 4) = a3;
            __syncthreads();
            { const int b = tid >> 7, col = tid & 127;
              if (col < 96) { float s = p.b_mod[l * 6 * DM + n0 + col];
#pragma unroll
                for (int k2 = 0; k2 < 16; ++k2) s += red[(k2 * 4 + b) * 128 + col];
                mod[((size_t)l * 4 + b) * (6 * DM) + n0 + col] = s; } }
            __syncthreads();
        } else {
            const int idx = (item - N_GEMV) * 512 + tid, pos = idx >> 6, j = idx & 63;
            double invd = 1.0;
#pragma nounroll
            for (int k = 0; k < j; ++k) invd *= 0.86596432336006535;
            const float inv = (float)invd;
            const float ang = (float)pos * inv;
            const double xd = (double)ang, kk = rint(xd * 0.15915494309189535), y = xd - kk * 6.283185307179586, y2 = y * y;
            double s = 1.0, c = 1.0;
#pragma nounroll
            for (int k = 13; k >= 1; --k) { s = 1.0 - s * y2 / (double)((2 * k) * (2 * k + 1)); c = 1.0 - c * y2 / (double)((2 * k - 1) * (2 * k)); }
            ((float*)(p.ws + WS_COS))[idx] = (float)c; ((float*)(p.ws + WS_SIN))[idx] = (float)(y * s);
        }
    }
    auto decode = [&](int tt, const float*& src, bf16_t*& dst, int& K, int& N, int& mode, int& n0, int& k0) {
        const int l = tt / 6144, u = tt % 6144; int v;
        if (u < 1536) { mode = 2; K = DM; N = DIN; v = u; src = p.w_in + (size_t)l * DM * DIN; dst = (bf16_t*)(p.ws + WS_WT_IN) + (size_t)l * DIN * LDU; }
        else if (u < 2048) { mode = 1; K = DM; N = DM; v = u - 1536; src = p.w_out + (size_t)l * DM * DM; dst = (bf16_t*)(p.ws + WS_WT_OUT) + (size_t)l * DM * LDU; }
        else if (u < 4096) { mode = 1; K = DM; N = DFF; v = u - 2048; src = p.w_ff1 + (size_t)l * DM * DFF; dst = (bf16_t*)(p.ws + WS_WT_FF1) + (size_t)l * DFF * LDU; }
        else { mode = 1; K = DFF; N = DM; v = u - 4096; src = p.w_ff2 + (size_t)l * DFF * DM; dst = (bf16_t*)(p.ws + WS_WT_FF2) + (size_t)l * DM * LDH; }
        const int ntn = N >> 6, kt = v / ntn, nt = v % ntn;
        src += (size_t)(kt * 128) * N + nt * 64; n0 = nt * 64; k0 = kt * 128;
    };
    const int lk = tid >> 4, ln4 = tid & 15;
    const int sn = tid >> 4, skc = tid & 15;
    int tt = item - FIRST_TR;
    if (tt < N_TR) {
        const float* src; bf16_t* dst; int K, N, mode, n0, k0; decode(tt, src, dst, K, N, mode, n0, k0);
        f32x4 rg[4];
#pragma unroll
        for (int i = 0; i < 4; ++i) rg[i] = *(const f32x4*)(src + (size_t)(lk + 32 * i) * N + ln4 * 4);
        for (;;) {
#pragma unroll
            for (int i = 0; i < 4; ++i) { LAS float* tp = tile + (lk + 32 * i) * 65 + ln4 * 4; tp[0] = rg[i][0]; tp[1] = rg[i][1]; tp[2] = rg[i][2]; tp[3] = rg[i][3]; }
            __syncthreads();
            bf16_t* cdst = dst; const int cnkt = K >> 6, cmode = mode, cn0 = n0, ck0 = k0;
            const int tn = tt + G;
            if (tn < N_TR) { decode(tn, src, dst, K, N, mode, n0, k0);
#pragma unroll
                for (int i = 0; i < 4; ++i) rg[i] = *(const f32x4*)(src + (size_t)(lk + 32 * i) * N + ln4 * 4); }
#pragma unroll
            for (int i = 0; i < 2; ++i) {
                const int n = sn + 32 * i; const LAS float* tp = tile + (skc * 8) * 65 + n;
                u32x4 w; w.x = cvt_pk_bf16(tp[0], tp[65]); w.y = cvt_pk_bf16(tp[130], tp[195]); w.z = cvt_pk_bf16(tp[260], tp[325]); w.w = cvt_pk_bf16(tp[390], tp[455]);
                const int ng = cn0 + n, np = (ng & ~127) + pg8::bperm_inv(cmode, ng & 127);
                *(u32x4*)(cdst + pg8::tiled_off(np, ck0 + skc * 8, cnkt)) = w;
            }
            __syncthreads();
            if (tn >= N_TR) break;
            tt = tn;
        }
    }
}

template <bool DO_LN>
__device__ __forceinline__ void row_phase(const float* xin, bf16_t* zb, float* xout, const float* g, const float* bta, const float* modl, int sc_off, int sh_off, bf16_t* U, float* stats, int rbase) {
    const int tid = opaque_tid(), wid = tid >> 6, lane = tid & 63;
    const int rstep = rbase >= 0 ? 8 : (int)gridDim.x * 8, rend = rbase >= 0 ? rbase + 64 : T_TOK;
    f32x4 vn[8]; u32x2 vb[8];
    int row = (rbase >= 0 ? rbase : (int)blockIdx.x * 8) + wid;
    if (row < rend) {
#pragma unroll
        for (int i = 0; i < 8; ++i) { if (DO_LN) vb[i] = *(const u32x2*)(zb + (size_t)row * DM + lane * 4 + i * 256); else vn[i] = *(const f32x4*)(xin + (size_t)row * DM + lane * 4 + i * 256); }
    }
    for (; row < rend; row += rstep) {
        f32x4 v[8], scv[8], shv[8];
#pragma unroll
        for (int i = 0; i < 8; ++i) { if (DO_LN) v[i] = (f32x4){bflo(vb[i].x), bfhi(vb[i].x), bflo(vb[i].y), bfhi(vb[i].y)}; else v[i] = vn[i]; }
        { const int nrow = row + rstep;
          if (nrow < rend) {
#pragma unroll
              for (int i = 0; i < 8; ++i) { if (DO_LN) vb[i] = *(const u32x2*)(zb + (size_t)nrow * DM + lane * 4 + i * 256); else vn[i] = *(const f32x4*)(xin + (size_t)nrow * DM + lane * 4 + i * 256); }
          } }
        if (DO_LN) {
            float s = 0.f;
#pragma unroll
            for (int i = 0; i < 8; ++i) s += (v[i][0] + v[i][1]) + (v[i][2] + v[i][3]);
#pragma unroll
            for (int o = 32; o >= 1; o >>= 1) s += __shfl_xor(s, o);
            const float mu = s * (1.0f / DM);
            float q = 0.f;
#pragma unroll
            for (int i = 0; i < 8; ++i) { v[i] -= mu; q += (v[i][0] * v[i][0] + v[i][1] * v[i][1]) + (v[i][2] * v[i][2] + v[i][3] * v[i][3]); }
#pragma unroll
            for (int o = 32; o >= 1; o >>= 1) q += __shfl_xor(q, o);
            const float rstd = rsqrtf(q * (1.0f / DM) + 1e-5f);
            const unsigned voff = (unsigned)lane * 16u;
            {
                f32x4 gg[8], bb[8];
#pragma unroll
                for (int i = 0; i < 8; ++i) { gg[i] = *(const f32x4*)((const char*)g + (voff + (unsigned)i * 1024u)); bb[i] = *(const f32x4*)((const char*)bta + (voff + (unsigned)i * 1024u)); }
#pragma unroll
                for (int i = 0; i < 8; ++i) v[i] = v[i] * rstd * gg[i] + bb[i];
            }
            if (U) {
                const char* mb = (const char*)(modl + (size_t)(row >> 12) * (6 * DM));
#pragma unroll
                for (int i = 0; i < 8; ++i) { scv[i] = *(const f32x4*)(mb + ((unsigned)sc_off * 4u + voff + (unsigned)i * 1024u)); shv[i] = *(const f32x4*)(mb + ((unsigned)sh_off * 4u + voff + (unsigned)i * 1024u)); }
            }
            if (stats) { if (lane == 0) *(f32x2*)(stats + 2 * row) = (f32x2){mu, rstd}; }
            else {
                float* op = xout + (size_t)row * DM + lane * 4;
#pragma unroll
                for (int i = 0; i < 8; ++i) *(f32x4*)(op + i * 256) = v[i];
            }
        }
        if (U) {
            if (!DO_LN) {
                const unsigned voff = (unsigned)lane * 16u;
                const char* mb = (const char*)(modl + (size_t)(row >> 12) * (6 * DM));
#pragma unroll
                for (int i = 0; i < 8; ++i) { scv[i] = *(const f32x4*)(mb + ((unsigned)sc_off * 4u + voff + (unsigned)i * 1024u)); shv[i] = *(const f32x4*)(mb + ((unsigned)sh_off * 4u + voff + (unsigned)i * 1024u)); }
            }
#pragma unroll
            for (int i = 0; i < 8; ++i) {
                const f32x4 uu = v[i] * (scv[i] + 1.0f) + shv[i];
                u32x2 w; w.x = cvt_pk_bf16(uu[0], uu[1]); w.y = cvt_pk_bf16(uu[2], uu[3]);
                *(u32x2*)(U + pg8::tiled_off(row, i * 256 + lane * 4, DM / 64)) = w;
                if (!DO_LN) { u32x2 wz; wz.x = cvt_pk_bf16(v[i][0], v[i][1]); wz.y = cvt_pk_bf16(v[i][2], v[i][3]); *(u32x2*)(zb + (size_t)row * DM + lane * 4 + i * 256) = wz; }
            }
        }
    }
}

struct AttnStep { size_t tb; int h, dl, r, n, br, first; };
__device__ __forceinline__ AttnStep attn_step(int wg, int q, int mode) {
    AttnStep a;
    if (mode) { const int bh = wg >> 3; a.tb = (size_t)(bh >> 3) * SEQ; a.h = bh & 7; a.br = 0; a.dl = 0; a.r = 0; a.n = 4 * (wg & 7) + q; a.first = (q == 0); }
    else if (wg < 128) { a.tb = (size_t)(wg >> 5) * SEQ; a.h = (wg >> 2) & 7; a.br = 1; a.dl = 2; a.r = wg & 3; a.n = q; a.first = (q == 0); }
    else { const int c16 = (wg - 128) * 4 + (q >> 1); a.tb = (size_t)(c16 >> 7) * SEQ; a.h = (c16 >> 4) & 7; a.br = 2; a.dl = 4; a.r = c16 & 15; a.n = q & 1; a.first = !(q & 1); }
    return a;
}
__device__ __forceinline__ void attn_phase(const Params& p, LAS unsigned char* lds, int l, int mode, int vc) {
    const bf16_t* proj = (const bf16_t*)(p.ws + WS_PROJ);
    bf16_t* opart = (bf16_t*)(p.ws + WS_OPART); float* lse = (float*)(p.ws + WS_LSE);
    bf16_t* mixed = (bf16_t*)(p.ws + WS_U);
    const float* gain = p.mix_g + (size_t)l * DM;
    const int tid = opaque_tid(), wid = tid >> 6, lane = tid & 63, li = lane & 15, g = lane >> 4;
    LAS unsigned char* Kl = lds; LAS unsigned char* Vl = lds + 256 * 272;
    constexpr int KH = 128 * 272, VH = 128 * 288;
    const int nsteps = mode ? 4 : 8;
    u32x4 kv[4], vv[4]; bf16x8 qf[4];
#define ATTN_LOAD_BLK(A, NB) do { _Pragma("unroll") for (int i = 0; i < 4; ++i) { const int idx = tid + 512 * i, row = idx >> 4, ch = idx & 15; \
            const bf16_t* src = proj + ((A).tb + ((size_t)((NB) * 128 + row) << (A).dl) + (A).r) * DIN + (A).h * 128 + ch * 8; kv[i] = *(const u32x4*)(src + 1024); vv[i] = *(const u32x4*)(src + 2048); } } while (0)
#define ATTN_STORE_BLK(HH) do { _Pragma("unroll") for (int i = 0; i < 4; ++i) { const int idx = tid + 512 * i, row = idx >> 4, ch = idx & 15; \
            *(LAS u32x4*)(Kl + (HH) * KH + row * 272 + ch * 16) = kv[i]; *(LAS u32x4*)(Vl + (HH) * VH + row * 288 + ch * 16) = vv[i]; } } while (0)
#define ATTN_LOAD_Q(A) do { const size_t qt_ = (A).tb + ((size_t)((A).n * 128 + wid * 16 + li) << (A).dl) + (A).r; \
            _Pragma("unroll") for (int s = 0; s < 4; ++s) qf[s] = *(const bf16x8*)(proj + qt_ * DIN + (A).h * 128 + s * 32 + g * 8); } while (0)
    const bool xown = gridDim.x == 256;
    const int xj = vc >> 3, xx = vc & 7;
    const int wg0 = !xown ? (int)blockIdx.x : mode ? 32 * xx + xj : (xj < 16 ? 16 * xx + xj : 128 + 16 * xx + (xj - 16));
    for (int wg = wg0; wg < 256; wg += xown ? 256 : (int)gridDim.x) {
        AttnStep cur = attn_step(wg, 0, mode);
        if (mode && cur.n > 0) { ATTN_LOAD_BLK(cur, cur.n - 1); ATTN_STORE_BLK(1); }
        ATTN_LOAD_BLK(cur, cur.n); ATTN_LOAD_Q(cur);
        for (int q = 0; q < nsteps; ++q) {
            const int c = q & 1;
            if (cur.first && cur.n == 0) {
#pragma unroll
                for (int i = 0; i < 4; ++i) { const int idx = tid + 512 * i, row = idx >> 4, ch = idx & 15;
                    *(LAS u32x4*)(Kl + (c ^ 1) * KH + row * 272 + ch * 16) = (u32x4){0u, 0u, 0u, 0u}; *(LAS u32x4*)(Vl + (c ^ 1) * VH + row * 288 + ch * 16) = (u32x4){0u, 0u, 0u, 0u}; }
            }
            ATTN_STORE_BLK(c);
            bf16x8 qc[4];
#pragma unroll
            for (int s = 0; s < 4; ++s) qc[s] = qf[s];
            asm volatile("s_waitcnt lgkmcnt(0)" ::: "memory"); __builtin_amdgcn_s_barrier(); asm volatile("" ::: "memory");
            AttnStep nxt = attn_step(wg, (q + 1 < nsteps) ? q + 1 : q, mode);
            if (q + 1 < nsteps) { ATTN_LOAD_BLK(nxt, nxt.n); ATTN_LOAD_Q(nxt); }
            const int n = cur.n, dl = cur.dl, h = cur.h, mbase = (n - 1) * 128;
            const int qi = wid * 16 + li; const size_t qtok = cur.tb + ((size_t)(n * 128 + qi) << dl) + cur.r;
            const int kb0 = wid & ~1;
            const int koffP = (c ^ 1) * KH, koffC = c * KH, voffP = (c ^ 1) * VH, voffC = c * VH;
            f32x4 sacc[10];
#pragma unroll
            for (int i = 0; i < 10; ++i) {
                sacc[i] = (f32x4){0.f, 0.f, 0.f, 0.f};
                const int kb = kb0 + i, koff = (kb < 8) ? koffP + kb * (16 * 272) : koffC + (kb - 8) * (16 * 272);
#pragma unroll
                for (int s = 0; s < 4; ++s) {
                    const bf16x8 kf = *(const LAS bf16x8*)(Kl + koff + li * 272 + (32 * s + 8 * g) * 2);
                    sacc[i] = __builtin_amdgcn_mfma_f32_16x16x32_bf16(kf, qc[s], sacc[i], 0, 0, 0);
                }
            }
            float mx = -1e30f;
#pragma unroll
            for (int i = 0; i < 10; ++i)
#pragma unroll
                for (int j = 0; j < 4; ++j) {
                    const int kj = 16 * (kb0 + i) + 4 * g + j, dist = 128 + qi - kj;
                    const bool valid = (dist >= 0) && (dist <= 128) && (mbase + kj >= 0);
                    const float sv = valid ? sacc[i][j] : -1e30f;
                    sacc[i][j] = sv; mx = fmaxf(mx, sv);
                }
            mx = fmaxf(mx, __shfl_xor(mx, 16)); mx = fmaxf(mx, __shfl_xor(mx, 32));
            float lsum = 0.f;
#pragma unroll
            for (int i = 0; i < 10; ++i)
#pragma unroll
                for (int j = 0; j < 4; ++j) { const float pv = __builtin_amdgcn_exp2f(sacc[i][j] - mx); sacc[i][j] = pv; lsum += pv; }
            lsum += __shfl_xor(lsum, 16); lsum += __shfl_xor(lsum, 32);
            u32x2 x1[8], x2[8]; float l1 = 0.f, l2 = 0.f;
            if (mode) {
                l1 = lse[qtok * 8 + h]; l2 = lse[((size_t)T_TOK + qtok) * 8 + h];
                const bf16_t* p1 = opart + qtok * 1024 + h * 128 + 4 * g; const bf16_t* p2 = p1 + (size_t)T_TOK * 1024;
#pragma unroll
                for (int db = 0; db < 8; ++db) { x1[db] = *(const u32x2*)(p1 + 16 * db); x2[db] = *(const u32x2*)(p2 + 16 * db); }
            }
            f32x4 oacc[8];
#pragma unroll
            for (int db = 0; db < 8; ++db) oacc[db] = (f32x4){0.f, 0.f, 0.f, 0.f};
            const int vlane = (4 * g + (li >> 2)) * 288 + (4 * (li & 3)) * 2;
#pragma unroll
            for (int t = 0; t < 5; ++t) {
                u32x4 pw; pw.x = cvt_pk_bf16(sacc[2 * t][0], sacc[2 * t][1]); pw.y = cvt_pk_bf16(sacc[2 * t][2], sacc[2 * t][3]);
                pw.z = cvt_pk_bf16(sacc[2 * t + 1][0], sacc[2 * t + 1][1]); pw.w = cvt_pk_bf16(sacc[2 * t + 1][2], sacc[2 * t + 1][3]);
                const bf16x8 pf = __builtin_bit_cast(bf16x8, pw);
                const int kbv = kb0 + 2 * t, voff = (kbv < 8) ? voffP + kbv * (16 * 288) : voffC + (kbv - 8) * (16 * 288);
                const LAS unsigned char* vb = Vl + voff + vlane;
#pragma unroll
                for (int db = 0; db < 8; ++db) {
                    const s16x4 lo = __builtin_bit_cast(s16x4, __builtin_amdgcn_ds_read_tr16_b64_v4i16((LAS s16x4*)(vb + db * 32)));
                    const s16x4 hi = __builtin_bit_cast(s16x4, __builtin_amdgcn_ds_read_tr16_b64_v4i16((LAS s16x4*)(vb + 16 * 288 + db * 32)));
                    const bf16x8 vf = __builtin_shufflevector(lo, hi, 0, 1, 2, 3, 4, 5, 6, 7);
                    oacc[db] = __builtin_amdgcn_mfma_f32_16x16x32_bf16(vf, pf, oacc[db], 0, 0, 0);
                }
            }
            const float inv = 1.0f / lsum, lse0 = mx + __builtin_amdgcn_logf(lsum);
            if (mode == 0) {
                bf16_t* op = opart + ((size_t)(cur.br - 1) * T_TOK + qtok) * 1024 + h * 128 + 4 * g;
#pragma unroll
                for (int db = 0; db < 8; ++db) { const f32x4 o = oacc[db] * inv; u32x2 w; w.x = cvt_pk_bf16(o[0], o[1]); w.y = cvt_pk_bf16(o[2], o[3]); *(u32x2*)(op + 16 * db) = w; }
                if (g == 0) lse[((size_t)(cur.br - 1) * T_TOK + qtok) * 8 + h] = lse0;
            } else {
                const float lm = fmaxf(lse0, fmaxf(l1, l2));
                const float w0 = __builtin_amdgcn_exp2f(lse0 - lm), w1 = __builtin_amdgcn_exp2f(l1 - lm), w2 = __builtin_amdgcn_exp2f(l2 - lm);
                const float wi = 1.0f / (w0 + w1 + w2), a0 = w0 * wi * inv, a1 = w1 * wi, a2 = w2 * wi;
                float ss = 0.f;
#pragma unroll
                for (int db = 0; db < 8; ++db) {
                    f32x4 o = oacc[db] * a0;
                    o[0] += bflo(x1[db].x) * a1 + bflo(x2[db].x) * a2; o[1] += bfhi(x1[db].x) * a1 + bfhi(x2[db].x) * a2;
                    o[2] += bflo(x1[db].y) * a1 + bflo(x2[db].y) * a2; o[3] += bfhi(x1[db].y) * a1 + bfhi(x2[db].y) * a2;
                    oacc[db] = o; ss += (o[0] * o[0] + o[1] * o[1]) + (o[2] * o[2] + o[3] * o[3]);
                }
                ss += __shfl_xor(ss, 16); ss += __shfl_xor(ss, 32);
                const float rs = rsqrtf(ss * (1.0f / 128.0f) + 1e-6f);
                f32x4 ggv[8];
#pragma unroll
                for (int db = 0; db < 8; ++db) ggv[db] = *(const f32x4*)(gain + h * 128 + 16 * db + 4 * g);
#pragma unroll
                for (int db = 0; db < 8; ++db) {
                    const f32x4 gg = ggv[db];
                    const f32x4 o = oacc[db] * rs * gg;
                    u32x2 w; w.x = cvt_pk_bf16(o[0], o[1]); w.y = cvt_pk_bf16(o[2], o[3]);
                    *(u32x2*)(mixed + pg8::tiled_off((int)qtok, h * 128 + 16 * db + 4 * g, DM / 64)) = w;
                }
            }
            asm volatile("s_waitcnt lgkmcnt(0)" ::: "memory"); __builtin_amdgcn_s_barrier(); asm volatile("" ::: "memory");
            cur = nxt;
        }
    }
#undef ATTN_LOAD_BLK
#undef ATTN_STORE_BLK
#undef ATTN_LOAD_Q
}

__device__ __forceinline__ void conv_phase(const Params& p, int l) {
    const bf16_t* proj = (const bf16_t*)(p.ws + WS_PROJ);
    bf16_t* mixed = (bf16_t*)(p.ws + WS_U);
    const float* gain = p.mix_g + (size_t)l * DM; const float* cw = p.conv_w + (size_t)l * 3 * 1024;
    const int tid = opaque_tid(), wid = tid >> 6, lane = tid & 63;
    u32x2 ngb[4], ngc0[4], nhi0[4], ngc1[4], nhi1[4], ngc2[4], nhi2[4];
#define CONV_LOAD(T) do { const int pos_ = (T) & (SEQ - 1); _Pragma("unroll") for (int i = 0; i < 4; ++i) { \
            const bf16_t* pr = proj + (size_t)(T) * DIN + i * 256 + lane * 4; \
            ngb[i] = *(const u32x2*)(pr + 3072); ngc0[i] = *(const u32x2*)(pr + 4096); nhi0[i] = *(const u32x2*)(pr + 5120); \
            ngc1[i] = (u32x2){0u, 0u}; nhi1[i] = ngc1[i]; ngc2[i] = ngc1[i]; nhi2[i] = ngc1[i]; \
            if (pos_ >= 1) { ngc1[i] = *(const u32x2*)(pr - DIN + 4096); nhi1[i] = *(const u32x2*)(pr - DIN + 5120); } \
            if (pos_ >= 2) { ngc2[i] = *(const u32x2*)(pr - 2 * DIN + 4096); nhi2[i] = *(const u32x2*)(pr - 2 * DIN + 5120); } } } while (0)
    int t = blockIdx.x * 8 + wid;
    if (t < T_TOK) CONV_LOAD(t);
    for (; t < T_TOK; t += gridDim.x * 8) {
        u32x2 gb[4], gc0[4], hi0[4], gc1[4], hi1[4], gc2[4], hi2[4];
#pragma unroll
        for (int i = 0; i < 4; ++i) { gb[i] = ngb[i]; gc0[i] = ngc0[i]; hi0[i] = nhi0[i]; gc1[i] = ngc1[i]; hi1[i] = nhi1[i]; gc2[i] = ngc2[i]; hi2[i] = nhi2[i]; }
        { const int tn = t + gridDim.x * 8; if (tn < T_TOK) CONV_LOAD(tn); }
        f32x4 cw0[4], cw1[4], cw2[4], g2[4];
#pragma unroll
        for (int i = 0; i < 4; ++i) { const int col = i * 256 + lane * 4;
            cw0[i] = *(const f32x4*)(cw + col); cw1[i] = *(const f32x4*)(cw + 1024 + col); cw2[i] = *(const f32x4*)(cw + 2048 + col); g2[i] = *(const f32x4*)(gain + 1024 + col); }
#pragma unroll
        for (int i = 0; i < 4; ++i) {
            const int col = i * 256 + lane * 4;
            f32x4 c0, c1, c2, gbv;
            c0[0] = bflo(gc0[i].x) * bflo(hi0[i].x); c0[1] = bfhi(gc0[i].x) * bfhi(hi0[i].x); c0[2] = bflo(gc0[i].y) * bflo(hi0[i].y); c0[3] = bfhi(gc0[i].y) * bfhi(hi0[i].y);
            c1[0] = bflo(gc1[i].x) * bflo(hi1[i].x); c1[1] = bfhi(gc1[i].x) * bfhi(hi1[i].x); c1[2] = bflo(gc1[i].y) * bflo(hi1[i].y); c1[3] = bfhi(gc1[i].y) * bfhi(hi1[i].y);
            c2[0] = bflo(gc2[i].x) * bflo(hi2[i].x); c2[1] = bfhi(gc2[i].x) * bfhi(hi2[i].x); c2[2] = bflo(gc2[i].y) * bflo(hi2[i].y); c2[3] = bfhi(gc2[i].y) * bfhi(hi2[i].y);
            gbv[0] = bflo(gb[i].x); gbv[1] = bfhi(gb[i].x); gbv[2] = bflo(gb[i].y); gbv[3] = bfhi(gb[i].y);
            f32x4 y = gbv * (cw0[i] * c2 + cw1[i] * c1 + cw2[i] * c0);
            float s2 = (y[0] * y[0] + y[1] * y[1]) + (y[2] * y[2] + y[3] * y[3]);
#pragma unroll
            for (int sft = 16; sft >= 1; sft >>= 1) s2 += __shfl_xor(s2, sft);
            const float rs2 = rsqrtf(s2 * (1.0f / 128.0f) + 1e-6f);
            y = y * rs2 * g2[i];
            u32x2 wy; wy.x = cvt_pk_bf16(y[0], y[1]); wy.y = cvt_pk_bf16(y[2], y[3]);
            *(u32x2*)(mixed + pg8::tiled_off(t, 1024 + col, DM / 64)) = wy;
        }
    }
#undef CONV_LOAD
}

#define XB_TMO      128
#define XB_XCNT(j)  (256  + 64 * (j))
#define XB_XSUB(j)  (1280 + 64 * (j))
#define XB_XGEN(j)  (2304 + 64 * (j))
#define XB_TOP      3328
#define XB_TOPGEN   3392
#define XB_LSUB(j)  (3456 + 64 * (j))
#define XB_LGEN(j)  (3968 + 64 * (j))
#define XCD_BAR_WORDS 4480
#define XB_SPIN_CAP (1u << 22)
__device__ __forceinline__ unsigned xb_ld(unsigned* p)              { return __hip_atomic_load(p, __ATOMIC_RELAXED, __HIP_MEMORY_SCOPE_AGENT); }
__device__ __forceinline__ unsigned xb_add(unsigned* p, unsigned v) { return __hip_atomic_fetch_add(p, v, __ATOMIC_RELAXED, __HIP_MEMORY_SCOPE_AGENT); }
#define XB_SPIN(cond, bar) do { unsigned _sp = 0; while (cond) { __builtin_amdgcn_s_sleep(1); \
    if ((++_sp & 255u) == 0u) { if (xb_ld(&(bar)[XB_TMO])) break; if (_sp > XB_SPIN_CAP) { atomicAdd(&(bar)[XB_TMO], 1u); break; } } } } while (0)
struct XcdBarrier { unsigned* bar; unsigned x; volatile LAS unsigned* st; };
__device__ __forceinline__ void xcd_barrier_complete(unsigned* bar, unsigned x, unsigned& nloc, unsigned& nx) {
    const unsigned G = gridDim.x * gridDim.y * gridDim.z;
    unsigned sum, cnt, mine, sp = 0u;
    for (;;) {
        sum = 0u; cnt = 0u; mine = 0u;
#pragma unroll
        for (unsigned j = 0; j < 16; ++j) { const unsigned c = xb_ld(&bar[XB_XCNT(j)]); sum += c; cnt += (c > 0u) ? 1u : 0u; mine = (j == x) ? c : mine; }
        if (sum == G) break;
        __builtin_amdgcn_s_sleep(1);
        if ((++sp & 255u) == 0u) { if (xb_ld(&bar[XB_TMO])) break; if (sp > XB_SPIN_CAP) { atomicAdd(&bar[XB_TMO], 1u); break; } }
    }
    nloc = mine > 0u ? mine : 1u; nx = cnt > 0u ? cnt : 1u;
}
__device__ __forceinline__ void xcd_barrier(const XcdBarrier& b) {
    asm volatile("s_waitcnt vmcnt(0)" ::: "memory");
    __syncthreads();
    if (threadIdx.x == 0) {
        unsigned* bar = b.bar;
        __builtin_amdgcn_s_waitcnt(0);
        unsigned nloc = b.st[0], nx = b.st[1];
        if (nloc == 0u) { xcd_barrier_complete(bar, b.x, nloc, nx); b.st[0] = nloc; b.st[1] = nx; }
        const unsigned old = xb_add(&bar[XB_XSUB(b.x)], 1u);
        const unsigned gen = old / nloc;
        if (old + 1u == (gen + 1u) * nloc) {
            __builtin_amdgcn_fence(__ATOMIC_RELEASE, "agent");
            asm volatile("s_waitcnt vmcnt(0)" ::: "memory");
            const unsigned og = xb_add(&bar[XB_TOP], 1u);
            const unsigned tg = og / nx;
            if (og + 1u == (tg + 1u) * nx) xb_add(&bar[XB_TOPGEN], 1u);
            else XB_SPIN(xb_ld(&bar[XB_TOPGEN]) == tg, bar);
            __builtin_amdgcn_fence(__ATOMIC_ACQUIRE, "agent");
            xb_add(&bar[XB_XGEN(b.x)], 1u);
            asm volatile("s_waitcnt vmcnt(0)" ::: "memory");
        } else {
            XB_SPIN(xb_ld(&bar[XB_XGEN(b.x)]) == gen, bar);
            __builtin_amdgcn_fence(__ATOMIC_ACQUIRE, "agent");
            asm volatile("s_waitcnt vmcnt(0)" ::: "memory");
        }
    }
    __syncthreads();
}

__device__ __forceinline__ void xcd_local_barrier(const XcdBarrier& b, unsigned nloc) {
    asm volatile("s_waitcnt vmcnt(0)" ::: "memory");
    __syncthreads();
    if (threadIdx.x == 0) {
        unsigned* bar = b.bar;
        __builtin_amdgcn_s_waitcnt(0);
        const unsigned old = xb_add(&bar[XB_LSUB(b.x)], 1u);
        const unsigned gen = old / nloc;
        if (old + 1u == (gen + 1u) * nloc) xb_add(&bar[XB_LGEN(b.x)], 1u);
        else XB_SPIN(xb_ld(&bar[XB_LGEN(b.x)]) == gen, bar);
        __builtin_amdgcn_fence(__ATOMIC_ACQUIRE, "agent");
        asm volatile("s_waitcnt vmcnt(0)" ::: "memory");
    }
    __syncthreads();
}

__global__ void __launch_bounds__(512, 2) fwd_megakernel(Params p) {
    extern __shared__ __attribute__((aligned(16))) unsigned char shm[];
    LAS unsigned char* lds = (LAS unsigned char*)shm;
    const float* mod = (const float*)(p.ws + WS_MOD);
    bf16_t* zb = (bf16_t*)(p.ws + WS_ZB);
    int vc = blockIdx.x, myrank = 0; bool xlocal = false;
    unsigned* bar = (unsigned*)(p.ws + WS_CTL);
    XcdBarrier xb; xb.bar = bar; xb.x = (unsigned)__builtin_amdgcn_s_getreg((3 << 11) | 20) & 0xFu; xb.st = (volatile LAS unsigned*)(lds + LDS_ST);
    const bool fused = (p.ph_hi - p.ph_lo) > 1;
    if (p.never) cg::this_grid().sync();
    if (fused) {
        if (threadIdx.x == 0) { xb.st[0] = 0u; xb.st[1] = 0u; xb.st[2] = xb_add(&bar[XB_XCNT(xb.x)], 1u); }
        __syncthreads();
        myrank = (int)xb.st[2];
    }
    for (int ph = p.ph_lo; ph < p.ph_hi; ++ph) {
        if (ph > p.ph_lo) {
            const int sb = (ph - 2) & 7;
            if (ph >= 2 && xlocal && (sb >= 4 || sb == 2)) xcd_local_barrier(xb, gridDim.x / 8); else xcd_barrier(xb);
        }
        if (ph == 1 && fused) {
            unsigned cc[16];
#pragma unroll
            for (int i = 0; i < 16; ++i) cc[i] = xb_ld(&bar[XB_XCNT(i)]);
            unsigned bad = gridDim.x & 7u;
#pragma unroll
            for (int i = 0; i < 16; ++i) bad |= cc[i] ^ (i < 8 ? gridDim.x / 8 : 0u);
            if (bad == 0u) { vc = myrank * 8 + (int)xb.x; xlocal = gridDim.x == 256; }
        }
        if (ph == 0) { pro_a_phase(p, lds); continue; }
        if (ph == 1) { row_phase<false>(p.x, zb, nullptr, nullptr, nullptr, mod, 1 * DM, 0, (bf16_t*)(p.ws + WS_U), nullptr, -1); continue; }
        const int l = (ph - 2) >> 3, s = (ph - 2) & 7;
        const float* modl = mod + (size_t)l * 4 * 6 * DM;
        float* stats = (float*)(p.ws + WS_STATS);
        const int rown = gridDim.x == 256 ? (vc & 7) * 2048 + (vc >> 3) * 64 : -1;
        pg8::StaticOrder S;
        if (s == 0) {
            pg8::Gemm g{(const bf16_t*)(p.ws + WS_U), (const bf16_t*)(p.ws + WS_WT_IN) + (size_t)l * DIN * LDU, T_TOK, DIN, DM, LDU, LDU};
            S.init(g.M, g.N, gridDim.x, vc);
            pg8::EpiProj E{(bf16_t*)(p.ws + WS_PROJ), (const float*)(p.ws + WS_COS), (const float*)(p.ws + WS_SIN)};
            pg8::gemm_phase<pg8::EpiProj>(lds, g, S, E);
        } else if (s == 1) {
            attn_phase(p, lds, l, 0, vc); conv_phase(p, l);
        } else if (s == 2) {
            attn_phase(p, lds, l, 1, vc);
        } else if (s == 3 || s == 6) {
            pg8::Gemm g; pg8::EpiRes E;
            if (s == 3) { g = pg8::Gemm{(const bf16_t*)(p.ws + WS_U), (const bf16_t*)(p.ws + WS_WT_OUT) + (size_t)l * DM * LDU, T_TOK, DM, DM, LDU, LDU};
                          E = pg8::EpiRes{zb, modl + 2 * DM, l == 0 ? nullptr : stats, p.ln2_g + (size_t)(l - (l > 0)) * DM, p.ln2_b + (size_t)(l - (l > 0)) * DM}; }
            else        { g = pg8::Gemm{(const bf16_t*)(p.ws + WS_H), (const bf16_t*)(p.ws + WS_WT_FF2) + (size_t)l * DM * LDH, T_TOK, DM, DFF, LDH, LDH};
                          E = pg8::EpiRes{zb, modl + 5 * DM, stats, p.ln1_g + (size_t)l * DM, p.ln1_b + (size_t)l * DM}; }
            S.init(g.M, g.N, gridDim.x, vc);
            pg8::gemm_phase<pg8::EpiRes>(lds, g, S, E);
        } else if (s == 4 || s == 7) {
            if (s == 4) row_phase<true>(nullptr, zb, p.out, p.ln1_g + (size_t)l * DM, p.ln1_b + (size_t)l * DM, modl, 4 * DM, 3 * DM, (bf16_t*)(p.ws + WS_U), stats, rown);
            else        row_phase<true>(nullptr, zb, p.out, p.ln2_g + (size_t)l * DM, p.ln2_b + (size_t)l * DM, modl + (size_t)4 * 6 * DM, 1 * DM, 0, (l + 1 < NLAYER) ? (bf16_t*)(p.ws + WS_U) : nullptr, (l + 1 < NLAYER) ? stats : nullptr, rown);
        } else {
            pg8::Gemm g{(const bf16_t*)(p.ws + WS_U), (const bf16_t*)(p.ws + WS_WT_FF1) + (size_t)l * DFF * LDU, T_TOK, DFF, DM, LDU, LDU};
            S.init(g.M, g.N, gridDim.x, vc);
            pg8::EpiFF1 E{(bf16_t*)(p.ws + WS_H)};
            pg8::gemm_phase<pg8::EpiFF1>(lds, g, S, E);
        }
    }
}

constexpr int N_PHASES = 2 + 8 * NLAYER;

extern "C" void kernel_launch(void* const* d_in, const int* in_sizes, int n_in, void* d_out, int out_size, void* d_ws, size_t ws_size, hipStream_t stream) {
    static int grid = 0;
    if (grid == 0) {
        int dev = 0, cus = 0, per_cu = 0;
        (void)hipGetDevice(&dev);
        (void)hipDeviceGetAttribute(&cus, hipDeviceAttributeMultiprocessorCount, dev);
        if (hipFuncSetAttribute((const void*)fwd_megakernel, hipFuncAttributeMaxDynamicSharedMemorySize, LDS_BYTES) != hipSuccess) fprintf(stderr, "hipFuncSetAttribute failed\n");
        if (hipOccupancyMaxActiveBlocksPerMultiprocessor(&per_cu, (const void*)fwd_megakernel, 512, LDS_BYTES) != hipSuccess || per_cu < 1) per_cu = 1;
        (void)hipGetLastError();
        grid = cus * per_cu;
        if (ws_size < WS_END) fprintf(stderr, "workspace too small: %zu < %zu\n", ws_size, (size_t)WS_END);
    }
    Params p{};
    p.x = (const float*)d_in[0]; p.c = (const float*)d_in[1]; p.w_in = (const float*)d_in[2]; p.conv_w = (const float*)d_in[3]; p.mix_g = (const float*)d_in[4];
    p.w_out = (const float*)d_in[5]; p.w_mod = (const float*)d_in[6]; p.b_mod = (const float*)d_in[7]; p.ln1_g = (const float*)d_in[8]; p.ln1_b = (const float*)d_in[9];
    p.w_ff1 = (const float*)d_in[10]; p.w_ff2 = (const float*)d_in[11]; p.ln2_g = (const float*)d_in[12]; p.ln2_b = (const float*)d_in[13];
    p.out = (float*)d_out; p.ws = (unsigned char*)d_ws;
#if SINGLE_LAUNCH
    (void)hipMemsetAsync((unsigned char*)d_ws + WS_CTL, 0, 20480, stream);
    p.ph_lo = 0; p.ph_hi = N_PHASES;
    void* args[] = {&p};
    hipError_t e = hipLaunchCooperativeKernel((const void*)fwd_megakernel, dim3(grid), dim3(512), args, LDS_BYTES, stream);
    if (e != hipSuccess) fprintf(stderr, "cooperative launch failed: %s (grid %d)\n", hipGetErrorString(e), grid);
#else
    for (int ph = 0; ph < N_PHASES; ++ph) {
        p.ph_lo = ph; p.ph_hi = ph + 1;
        hipLaunchKernelGGL(fwd_megakernel, dim3(grid), dim3(512), LDS_BYTES, stream, p);
    }
#endif
}
```

```cpp
#include <hip/hip_runtime.h>
#include <hip/hip_cooperative_groups.h>
#include <cstdio>
namespace cg = cooperative_groups;

#ifndef SINGLE_LAUNCH
#define SINGLE_LAUNCH 1
#endif

#define LAS __attribute__((address_space(3)))
typedef unsigned short bf16_t;
typedef short bf16x8 __attribute__((ext_vector_type(8)));
typedef short s16x4 __attribute__((ext_vector_type(4)));
typedef float f32x4 __attribute__((ext_vector_type(4)));
typedef float f32x2 __attribute__((ext_vector_type(2)));
typedef unsigned u32x4 __attribute__((ext_vector_type(4)));
typedef unsigned u32x2 __attribute__((ext_vector_type(2)));

constexpr int T_TOK = 16384, SEQ = 4096, DM = 2048, DIN = 6144, DFF = 8192, NLAYER = 2;
constexpr int KPAD = 0, LDU = DM + KPAD, LDH = DFF + KPAD;
constexpr float ALPHA = 1.4142135623730951f;
constexpr float QSCALE = 0.08838834764831845f * 1.4426950408889634f;

constexpr size_t WS_WT_IN = 0;
constexpr size_t WS_WT_OUT = WS_WT_IN + (size_t)NLAYER * DIN * LDU * 2;
constexpr size_t WS_WT_FF1 = WS_WT_OUT + (size_t)NLAYER * DM * LDU * 2;
constexpr size_t WS_WT_FF2 = WS_WT_FF1 + (size_t)NLAYER * DFF * LDU * 2;
constexpr size_t WS_MOD = WS_WT_FF2 + (size_t)NLAYER * DM * LDH * 2;
constexpr size_t WS_COS = WS_MOD + (size_t)NLAYER * 4 * 6 * DM * 4;
constexpr size_t WS_SIN = WS_COS + (size_t)SEQ * 64 * 4;
constexpr size_t WS_U = WS_SIN + (size_t)SEQ * 64 * 4;
constexpr size_t WS_PROJ = WS_U + (size_t)T_TOK * LDU * 2;
constexpr size_t WS_OPART = WS_PROJ + (size_t)T_TOK * DIN * 2;
constexpr size_t WS_LSE = WS_OPART + (size_t)3 * T_TOK * 1024 * 4;
constexpr size_t WS_CTL = WS_LSE + (size_t)3 * T_TOK * 8 * 4;
constexpr size_t WS_STATS = WS_CTL + 20480;
constexpr size_t WS_END = WS_STATS + (size_t)T_TOK * 2 * 4;
constexpr size_t WS_ZB = WS_OPART + (size_t)2 * T_TOK * 1024 * 2;
constexpr size_t WS_H = WS_PROJ;

constexpr int LDS_ST = 256 * 272 + 256 * 288;
constexpr int LDS_BYTES = LDS_ST + 16;

struct Params {
    const float* x; const float* c; const float* w_in; const float* conv_w; const float* mix_g; const float* w_out;
    const float* w_mod; const float* b_mod; const float* ln1_g; const float* ln1_b; const float* w_ff1; const float* w_ff2;
    const float* ln2_g; const float* ln2_b;
    float* out; unsigned char* ws;
    int ph_lo, ph_hi, never, pad;
};

__device__ __forceinline__ unsigned cvt_pk_bf16(float lo, float hi) { unsigned r; asm volatile("v_cvt_pk_bf16_f32 %0, %1, %2" : "=v"(r) : "v"(lo), "v"(hi)); return r; }
__device__ __forceinline__ int opaque_tid() { int t = threadIdx.x; asm volatile("" : "+v"(t)); return t; }
__device__ __forceinline__ float bf2f(unsigned short b) { return __uint_as_float(((unsigned)b) << 16); }
__device__ __forceinline__ float bflo(unsigned w) { return __uint_as_float(w << 16); }
__device__ __forceinline__ float bfhi(unsigned w) { return __uint_as_float(w & 0xffff0000u); }

namespace pg8 {
constexpr int BM = 256, BK = 64, HALF = 128, HTB = HALF * BK * 2, STAGE_BYTES = 8 * HTB, NXCD = 8, WGM = 8;
__device__ __forceinline__ int lds_byte(int r, int c) { const int st = (r >> 4) * 2 + (c >> 5), rr = r & 15, cc = c & 31, ob = rr * 64 + cc * 2; return st * 1024 + (ob ^ (((ob >> 9) & 1) << 5)); }
__device__ __forceinline__ void stage_rc(int b, int& R, int& C) { const int st = b / 1024, sb = b % 1024, swz = sb ^ (((sb >> 9) & 1) << 5); R = (st >> 1) * 16 + swz / 64; C = (st & 1) * 32 + (swz % 64) / 2; }
__device__ __forceinline__ int perm32(int rho) { const int n = rho >> 4, i = rho & 15; return 8 * (i >> 2) + 4 * n + (i & 3); }
__device__ __forceinline__ int bperm(int mode, int R) {
    if (mode == 1) return (R & ~31) + perm32(R & 31);
    if (mode == 2) return 64 * ((R >> 4) & 1) + 16 * (R >> 5) + (R & 15);
    return R;
}
__device__ __forceinline__ int bperm_inv(int mode, int s) {
    if (mode == 1) { const int t = s & 31; return (s & ~31) + 16 * ((t >> 2) & 1) + 4 * (t >> 3) + (t & 3); }
    if (mode == 2) return 32 * ((s >> 4) & 3) + 16 * (s >> 6) + (s & 15);
    return s;
}
__device__ __forceinline__ size_t tiled_off(int row, int k, int nkt) {
    return ((size_t)((row >> 7) * nkt + (k >> 6)) << 13) + (size_t)(lds_byte(row & 127, k & 63) >> 1);
}
struct Unit { int pm, pn; };
struct Gemm { const bf16_t* A; const bf16_t* Bt; int M, N, K, lda, ldb; };
struct StaticOrder {
    int nM, nN, nwg, G, c;
    __device__ void init(int M, int N, int G_, int c_) { nM = M / BM; nN = N / BM; nwg = nM * nN; G = G_; c = c_; }
    __device__ bool next(int i, Unit& u) const {
        const long L = (long)i * G + c; if (L >= nwg) return false;
        int wgid = (int)L; { const int q = nwg / NXCD, r = nwg % NXCD, xcd = wgid % NXCD, off = wgid / NXCD; wgid = (xcd < r ? xcd * (q + 1) : r * (q + 1) + (xcd - r) * q) + off; }
        const int nig = WGM * nN, gid = wgid / nig, fm = gid * WGM, gsz = (nM - fm) < WGM ? (nM - fm) : WGM;
        u.pm = fm + ((wgid % nig) % gsz); u.pn = (wgid % nig) / gsz; return true;
    }
};

template <class Epi>
__device__ __forceinline__ void gemm_phase(LAS unsigned char* lds, const Gemm g, const StaticOrder& S, const Epi& E) {
    const int tid = opaque_tid(), wid = __builtin_amdgcn_readfirstlane(tid >> 6), lane = tid & 63, wr = wid >> 2, wc = wid & 3, fr = lane & 15, fq = lane >> 4;
    const int K = g.K, nt = K / BK;
    unsigned voffA[2], voffB[2];
#pragma unroll
    for (int i = 0; i < 2; ++i) { voffA[i] = (unsigned)(tid * 16 + i * 8192); voffB[i] = voffA[i]; }
    const size_t kstep = (size_t)HTB;
    const size_t hstepA = (size_t)nt * HTB, hstepB = hstepA;
    const size_t tstepA = 2 * hstepA, tstepB = tstepA;
    const unsigned ldsw = (unsigned)wid * 1024u;
    const int aoff = lds_byte(wr * 64 + fr, fq * 8), boff = lds_byte(wc * 32 + fr, fq * 8);
#define PG8_SA(b, h) (((b) * 2 + (h)) * HTB)
#define PG8_SB(b, h) ((4 + (b) * 2 + (h)) * HTB)
#define PG8_STAGE(bufoff, gbase, voff) do { _Pragma("unroll") for (int _i = 0; _i < 2; ++_i) \
        __builtin_amdgcn_global_load_lds((const unsigned*)((const char*)(gbase) + (voff)[_i]), (LAS unsigned*)(lds + (bufoff) + ldsw + _i * 8192), 16, 0, 0); } while (0)
#define PG8_LDA(dst, b, h) do { _Pragma("unroll") for (int m = 0; m < 4; ++m) _Pragma("unroll") for (int k = 0; k < 2; ++k) dst[m][k] = *(const LAS bf16x8*)(lds + PG8_SA(b, h) + aoff + m * 2048 + k * 1024); } while (0)
#define PG8_LDB(dst, b, h) do { _Pragma("unroll") for (int n = 0; n < 2; ++n) _Pragma("unroll") for (int k = 0; k < 2; ++k) dst[n][k] = *(const LAS bf16x8*)(lds + PG8_SB(b, h) + boff + n * 2048 + k * 1024); } while (0)
#define PG8_MMA(ai, bj, At, Bt) do { __builtin_amdgcn_s_setprio(1); _Pragma("unroll") for (int m = 0; m < 4; ++m) _Pragma("unroll") for (int n = 0; n < 2; ++n) _Pragma("unroll") for (int k = 0; k < 2; ++k) \
        acc[ai][bj][m][n] = __builtin_amdgcn_mfma_f32_16x16x32_bf16(Bt[n][k], At[m][k], acc[ai][bj][m][n], 0, 0, 0); __builtin_amdgcn_s_setprio(0); } while (0)
#define PG8_WAIT_V(n) asm volatile("s_waitcnt vmcnt(" #n ")" ::: "memory")
#define PG8_WAIT_L(n) asm volatile("s_waitcnt lgkmcnt(" #n ")" ::: "memory")
#define PG8_BAR __builtin_amdgcn_s_barrier()
#define PG8_SCHED __builtin_amdgcn_sched_barrier(0)
    Unit cur, nxt; int ui = 0;
    if (!S.next(0, cur)) return;
    f32x4 acc[2][2][4][2];
#pragma unroll
    for (int a = 0; a < 2; ++a)
#pragma unroll
        for (int b = 0; b < 2; ++b)
#pragma unroll
            for (int m = 0; m < 4; ++m)
#pragma unroll
                for (int n = 0; n < 2; ++n) acc[a][b][m][n] = (f32x4){0.f, 0.f, 0.f, 0.f};
    bf16x8 At[4][2], B0[2][2], B1[2][2];
    const char* cA = (const char*)g.A + (size_t)cur.pm * tstepA; const char* cB = (const char*)g.Bt + (size_t)cur.pn * tstepB;
    PG8_STAGE(PG8_SB(0, 0), cB, voffB); PG8_STAGE(PG8_SA(0, 0), cA, voffA); PG8_STAGE(PG8_SB(0, 1), cB + hstepB, voffB); PG8_STAGE(PG8_SA(0, 1), cA + hstepA, voffA);
    if (wr == 1) PG8_BAR;
    PG8_WAIT_V(4); PG8_BAR;
    PG8_STAGE(PG8_SB(1, 0), cB + kstep, voffB); PG8_STAGE(PG8_SA(1, 0), cA + kstep, voffA); PG8_STAGE(PG8_SB(1, 1), cB + hstepB + kstep, voffB);
    PG8_WAIT_V(6); PG8_BAR;
    for (;;) {
        const bool has_next = S.next(ui + 1, nxt);
        const char* nA = has_next ? (const char*)g.A + (size_t)nxt.pm * tstepA : cA; const char* nB = has_next ? (const char*)g.Bt + (size_t)nxt.pn * tstepB : cB;
        for (int t = 0; t < nt; t += 2) {
            const bool last = (t == nt - 2);
            const char* a1 = cA + (size_t)(t + 1) * kstep;
            const char* a2 = last ? nA : cA + (size_t)(t + 2) * kstep; const char* b2 = last ? nB : cB + (size_t)(t + 2) * kstep;
            const char* a3 = a2 + kstep; const char* b3 = b2 + kstep;
            PG8_LDB(B0, 0, 0); PG8_SCHED; PG8_LDA(At, 0, 0); PG8_STAGE(PG8_SA(1, 1), a1 + hstepA, voffA);
            PG8_WAIT_L(8); PG8_BAR; PG8_WAIT_L(0); PG8_MMA(0, 0, At, B0); PG8_BAR; PG8_SCHED;
            PG8_LDB(B1, 0, 1); PG8_STAGE(PG8_SB(0, 0), b2, voffB);
            PG8_BAR; PG8_WAIT_L(0); PG8_MMA(0, 1, At, B1); PG8_BAR;
            PG8_LDA(At, 0, 1); PG8_STAGE(PG8_SA(0, 0), a2, voffA);
            PG8_BAR; PG8_WAIT_L(0); PG8_MMA(1, 0, At, B0); PG8_BAR; PG8_SCHED;
            PG8_STAGE(PG8_SB(0, 1), b2 + hstepB, voffB);
            PG8_WAIT_V(6); PG8_BAR; PG8_MMA(1, 1, At, B1); PG8_BAR;
            PG8_LDB(B0, 1, 0); PG8_SCHED; PG8_LDA(At, 1, 0); PG8_STAGE(PG8_SA(0, 1), a2 + hstepA, voffA);
            PG8_WAIT_L(8); PG8_BAR; PG8_WAIT_L(0); PG8_MMA(0, 0, At, B0); PG8_BAR; PG8_SCHED;
            PG8_LDB(B1, 1, 1); PG8_STAGE(PG8_SB(1, 0), b3, voffB);
            PG8_BAR; PG8_WAIT_L(0); PG8_MMA(0, 1, At, B1); PG8_BAR;
            PG8_LDA(At, 1, 1); PG8_STAGE(PG8_SA(1, 0), a3, voffA);
            PG8_BAR; PG8_WAIT_L(0); PG8_MMA(1, 0, At, B0); PG8_BAR; PG8_SCHED;
            PG8_STAGE(PG8_SB(1, 1), b3 + hstepB, voffB);
            PG8_WAIT_V(6); PG8_BAR; PG8_MMA(1, 1, At, B1); PG8_BAR;
        }
        E(acc, cur, wr, wc, fr, fq);
        if (!has_next) break;
#pragma unroll
        for (int a = 0; a < 2; ++a)
#pragma unroll
            for (int b = 0; b < 2; ++b)
#pragma unroll
                for (int m = 0; m < 4; ++m)
#pragma unroll
                    for (int n = 0; n < 2; ++n) acc[a][b][m][n] = (f32x4){0.f, 0.f, 0.f, 0.f};
        cur = nxt; cA = nA; cB = nB; ++ui;
    }
    PG8_WAIT_V(0);
    if (wr == 0) PG8_BAR;
    PG8_BAR;
#undef PG8_SA
#undef PG8_SB
#undef PG8_STAGE
#undef PG8_LDA
#undef PG8_LDB
#undef PG8_MMA
#undef PG8_WAIT_V
#undef PG8_WAIT_L
#undef PG8_BAR
#undef PG8_SCHED
}

struct EpiProj {
    static constexpr int PERM = 2;
    bf16_t* O; const float* cosT; const float* sinT;
    __device__ __forceinline__ void operator()(const f32x4 (&acc)[2][2][4][2], const Unit& u, int wr, int wc, int fr, int fq) const {
        const int row0 = u.pm * BM + wr * 64 + fr, j0 = wc * 16 + 4 * fq, colb = u.pn * BM + j0;
        if (u.pn < 8) {
            const float sc = (u.pn < 4) ? QSCALE : 1.0f;
#pragma unroll
            for (int ai = 0; ai < 2; ++ai) {
                f32x4 csv[4], snv[4];
#pragma unroll
                for (int m = 0; m < 4; ++m) { const int pos = (row0 + ai * HALF + m * 16) & (SEQ - 1); csv[m] = *(const f32x4*)(cosT + pos * 64 + j0); snv[m] = *(const f32x4*)(sinT + pos * 64 + j0); }
#pragma unroll
                for (int m = 0; m < 4; ++m) {
                    const int row = row0 + ai * HALF + m * 16;
                    const f32x4 cs = csv[m], sn = snv[m];
                    bf16_t* rowp = O + (size_t)row * DIN + colb;
#pragma unroll
                    for (int bj = 0; bj < 2; ++bj) {
                        const f32x4 a = acc[ai][bj][m][0], b = acc[ai][bj][m][1];
                        const f32x4 o1 = (a * cs - b * sn) * sc, o2 = (b * cs + a * sn) * sc;
                        u32x2 w1, w2; w1.x = cvt_pk_bf16(o1[0], o1[1]); w1.y = cvt_pk_bf16(o1[2], o1[3]); w2.x = cvt_pk_bf16(o2[0], o2[1]); w2.y = cvt_pk_bf16(o2[2], o2[3]);
                        *(u32x2*)(rowp + bj * HALF) = w1; *(u32x2*)(rowp + bj * HALF + 64) = w2;
                    }
                }
            }
        } else {
#pragma unroll
            for (int ai = 0; ai < 2; ++ai)
#pragma unroll
                for (int m = 0; m < 4; ++m) {
                    const int row = row0 + ai * HALF + m * 16;
                    bf16_t* rowp = O + (size_t)row * DIN + colb;
#pragma unroll
                    for (int bj = 0; bj < 2; ++bj) {
                        const f32x4 o1 = acc[ai][bj][m][0], o2 = acc[ai][bj][m][1];
                        u32x2 w1, w2; w1.x = cvt_pk_bf16(o1[0], o1[1]); w1.y = cvt_pk_bf16(o1[2], o1[3]); w2.x = cvt_pk_bf16(o2[0], o2[1]); w2.y = cvt_pk_bf16(o2[2], o2[3]);
                        *(u32x2*)(rowp + bj * HALF) = w1; *(u32x2*)(rowp + bj * HALF + 64) = w2;
                    }
                }
        }
    }
};
struct EpiRes {
    static constexpr int PERM = 1;
    bf16_t* z; const float* gate;
    const float* stats; const float* lng; const float* lnb;
    __device__ __forceinline__ void operator()(const f32x4 (&acc)[2][2][4][2], const Unit& u, int wr, int wc, int fr, int fq) const {
        const int row0 = u.pm * BM + wr * 64 + fr, col0 = u.pn * BM + wc * 32 + 8 * fq;
        const float* gb = gate + (size_t)(row0 >> 12) * (6 * DM);
        const bool ln = stats != nullptr;
        constexpr int GB[4] = {0, 4, 8, 16};
        f32x2 st[4];
#pragma unroll
        for (int grp = 0; grp < 3; ++grp) {
            u32x4 xv[8]; f32x4 cg[2][2], cl[2][2], cb[2][2];
            if (grp == 0 || grp == 2) {
#pragma unroll
                for (int m = 0; m < 4; ++m) st[m] = ln ? *(const f32x2*)(stats + 2 * (row0 + (grp ? HALF : 0) + m * 16)) : (f32x2){0.f, 1.f};
            }
#pragma unroll
            for (int j = GB[grp]; j < GB[grp + 1]; ++j) {
                const int k = j >> 2, m = j & 3, ai = k >> 1, col = col0 + (k & 1) * HALF, kk = k - (GB[grp] >> 2);
                if (m == 0) {
#pragma unroll
                    for (int n = 0; n < 2; ++n) { cg[kk][n] = *(const f32x4*)(gb + col + 4 * n) + 1.0f; cl[kk][n] = (f32x4){1.f, 1.f, 1.f, 1.f}; cb[kk][n] = (f32x4){0.f, 0.f, 0.f, 0.f};
                        if (ln) { cl[kk][n] = *(const f32x4*)(lng + col + 4 * n); cb[kk][n] = *(const f32x4*)(lnb + col + 4 * n); } }
                }
                xv[j - GB[grp]] = *(const u32x4*)(z + (size_t)(row0 + ai * HALF + m * 16) * DM + col);
            }
#pragma unroll
            for (int j = GB[grp]; j < GB[grp + 1]; ++j) {
                const int k = j >> 2, m = j & 3, ai = k >> 1, bj = k & 1, col = col0 + bj * HALF, kk = k - (GB[grp] >> 2);
                const u32x4 r = xv[j - GB[grp]];
                f32x4 x0 = {bflo(r.x), bfhi(r.x), bflo(r.y), bfhi(r.y)}, x1 = {bflo(r.z), bfhi(r.z), bflo(r.w), bfhi(r.w)};
                x0 = (x0 - st[m].x) * st[m].y * cl[kk][0] + cb[kk][0]; x1 = (x1 - st[m].x) * st[m].y * cl[kk][1] + cb[kk][1];
                const f32x4 o0 = x0 * ALPHA + cg[kk][0] * acc[ai][bj][m][0], o1 = x1 * ALPHA + cg[kk][1] * acc[ai][bj][m][1];
                u32x4 w; w.x = cvt_pk_bf16(o0[0], o0[1]); w.y = cvt_pk_bf16(o0[2], o0[3]); w.z = cvt_pk_bf16(o1[0], o1[1]); w.w = cvt_pk_bf16(o1[2], o1[3]);
                *(u32x4*)(z + (size_t)(row0 + ai * HALF + m * 16) * DM + col) = w;
            }
        }
    }
};
struct EpiFF1 {
    static constexpr int PERM = 1;
    bf16_t* O;
    __device__ __forceinline__ void operator()(const f32x4 (&acc)[2][2][4][2], const Unit& u, int wr, int wc, int fr, int fq) const {
        const int row0 = u.pm * BM + wr * 64 + fr, col0 = u.pn * BM + wc * 32 + 8 * fq;
#pragma unroll
        for (int ai = 0; ai < 2; ++ai)
#pragma unroll
            for (int m = 0; m < 4; ++m) {
                const int rowi = row0 + ai * HALF + m * 16;
#pragma unroll
                for (int bj = 0; bj < 2; ++bj) {
                    f32x4 v0 = acc[ai][bj][m][0], v1 = acc[ai][bj][m][1];
#pragma unroll
                    for (int j = 0; j < 4; ++j) { const float a = fmaxf(v0[j], 0.f), b = fmaxf(v1[j], 0.f); v0[j] = a * a; v1[j] = b * b; }
                    u32x4 w; w.x = cvt_pk_bf16(v0[0], v0[1]); w.y = cvt_pk_bf16(v0[2], v0[3]); w.z = cvt_pk_bf16(v1[0], v1[1]); w.w = cvt_pk_bf16(v1[2], v1[3]);
                    *(u32x4*)(O + tiled_off(rowi, col0 + bj * HALF, DFF / 64)) = w;
                }
            }
    }
};
}

__device__ __forceinline__ void pro_a_phase(const Params& p, LAS unsigned char* lds) {
    const int tid = opaque_tid();
    LAS float* cond = (LAS float*)lds;
    LAS float* red = (LAS float*)(lds + 32768);
    LAS float* tile = (LAS float*)(lds + 65536);
    float* mod = (float*)(p.ws + WS_MOD);
    const int G = gridDim.x;
    constexpr int N_GEMV = 256, N_ROPE = 512, N_TR = 12288, FIRST_TR = N_GEMV + N_ROPE;
    if ((int)blockIdx.x < N_GEMV) {
        for (int i = tid; i < 4 * DM; i += 512) { const float v = p.c[i]; cond[i] = v / (1.0f + __expf(-v)); }
        __syncthreads();
    }
    int item = blockIdx.x;
    for (; item < FIRST_TR; item += G) {
        if (item < N_GEMV) {
            const int l = item >> 7, n0 = (item & 127) * 96, cq = tid & 31, kg = tid >> 5;
            const float* wp = p.w_mod + (size_t)l * DM * (6 * DM) + (size_t)(kg * 128) * (6 * DM) + n0 + cq * 4;
            const LAS float* cp = cond + kg * 128;
            f32x4 a0 = {0.f, 0.f, 0.f, 0.f}, a1 = a0, a2 = a0, a3 = a0;
            if (cq < 24)
#pragma unroll 8
            for (int k = 0; k < 128; ++k) {
                const f32x4 w = *(const f32x4*)(wp + (size_t)k * (6 * DM));
                a0 += w * cp[k]; a1 += w * cp[DM + k]; a2 += w * cp[2 * DM + k]; a3 += w * cp[3 * DM + k];
            }
            *(LAS f32x4*)(red + (kg * 4 + 0) * 128 + cq * 4) = a0; *(LAS f32x4*)(red + (kg * 4 + 1) * 128 + cq * 4) = a1;
            *(LAS f32x4*)(red + (kg * 4 + 2) * 128 + cq * 4) = a2; *(LAS f32x4*)(red + (kg * 4 + 3) * 128 + cq * 4) = a3;
            __syncthreads();
            { const int b = tid >> 7, col = tid & 127;
              if (col < 96) { float s = p.b_mod[l * 6 * DM + n0 + col];
#pragma unroll
                for (int k2 = 0; k2 < 16; ++k2) s += red[(k2 * 4 + b) * 128 + col];
                mod[((size_t)l * 4 + b) * (6 * DM) + n0 + col] = s; } }
            __syncthreads();
        } else {
            const int idx = (item - N_GEMV) * 512 + tid, pos = idx >> 6, j = idx & 63;
            double invd = 1.0;
#pragma nounroll
            for (int k = 0; k < j; ++k) invd *= 0.86596432336006535;
            const float inv = (float)invd;
            const float ang = (float)pos * inv;
            const double xd = (double)ang, kk = rint(xd * 0.15915494309189535), y = xd - kk * 6.283185307179586, y2 = y * y;
            double s = 1.0, c = 1.0;
#pragma nounroll
            for (int k = 13; k >= 1; --k) { s = 1.0 - s * y2 / (double)((2 * k) * (2 * k + 1)); c = 1.0 - c * y2 / (double)((2 * k - 1) * (2 * k)); }
            ((float*)(p.ws + WS_COS))[idx] = (float)c; ((float*)(p.ws + WS_SIN))[idx] = (float)(y * s);
        }
    }
    auto decode = [&](int tt, const float*& src, bf16_t*& dst, int& K, int& N, int& mode, int& n0, int& k0) {
        const int l = tt / 6144, u = tt % 6144; int v;
        if (u < 1536) { mode = 2; K = DM; N = DIN; v = u; src = p.w_in + (size_t)l * DM * DIN; dst = (bf16_t*)(p.ws + WS_WT_IN) + (size_t)l * DIN * LDU; }
        else if (u < 2048) { mode = 1; K = DM; N = DM; v = u - 1536; src = p.w_out + (size_t)l * DM * DM; dst = (bf16_t*)(p.ws + WS_WT_OUT) + (size_t)l * DM * LDU; }
        else if (u < 4096) { mode = 1; K = DM; N = DFF; v = u - 2048; src = p.w_ff1 + (size_t)l * DM * DFF; dst = (bf16_t*)(p.ws + WS_WT_FF1) + (size_t)l * DFF * LDU; }
        else { mode = 1; K = DFF; N = DM; v = u - 4096; src = p.w_ff2 + (size_t)l * DFF * DM; dst = (bf16_t*)(p.ws + WS_WT_FF2) + (size_t)l * DM * LDH; }
        const int ntn = N >> 6, kt = v / ntn, nt = v % ntn;
        src += (size_t)(kt * 128) * N + nt * 64; n0 = nt * 64; k0 = kt * 128;
    };
    const int lk = tid >> 4, ln4 = tid & 15;
    const int sn = tid >> 4, skc = tid & 15;
    int tt = item - FIRST_TR;
    if (tt < N_TR) {
        const float* src; bf16_t* dst; int K, N, mode, n0, k0; decode(tt, src, dst, K, N, mode, n0, k0);
        f32x4 rg[4];
#pragma unroll
        for (int i = 0; i < 4; ++i) rg[i] = *(const f32x4*)(src + (size_t)(lk + 32 * i) * N + ln4 * 4);
        for (;;) {
#pragma unroll
            for (int i = 0; i < 4; ++i) { LAS float* tp = tile + (lk + 32 * i) * 65 + ln4 * 4; tp[0] = rg[i][0]; tp[1] = rg[i][1]; tp[2] = rg[i][2]; tp[3] = rg[i][3]; }
            __syncthreads();
            bf16_t* cdst = dst; const int cnkt = K >> 6, cmode = mode, cn0 = n0, ck0 = k0;
            const int tn = tt + G;
            if (tn < N_TR) { decode(tn, src, dst, K, N, mode, n0, k0);
#pragma unroll
                for (int i = 0; i < 4; ++i) rg[i] = *(const f32x4*)(src + (size_t)(lk + 32 * i) * N + ln4 * 4); }
#pragma unroll
            for (int i = 0; i < 2; ++i) {
                const int n = sn + 32 * i; const LAS float* tp = tile + (skc * 8) * 65 + n;
                u32x4 w; w.x = cvt_pk_bf16(tp[0], tp[65]); w.y = cvt_pk_bf16(tp[130], tp[195]); w.z = cvt_pk_bf16(tp[260], tp[325]); w.w = cvt_pk_bf16(tp[390], tp[455]);
                const int ng = cn0 + n, np = (ng & ~127) + pg8::bperm_inv(cmode, ng & 127);
                *(u32x4*)(cdst + pg8::tiled_off(np, ck0 + skc * 8, cnkt)) = w;
            }
            __syncthreads();
            if (tn >= N_TR) break;
            tt = tn;
        }
    }
}

template <bool DO_LN>
__device__ __forceinline__ void row_phase(const float* xin, bf16_t* zb, float* xout, const float* g, const float* bta, const float* modl, int sc_off, int sh_off, bf16_t* U, float* stats, int rbase) {
    const int tid = opaque_tid(), wid = tid >> 6, lane = tid & 63;
    const int rstep = rbase >= 0 ? 8 : (int)gridDim.x * 8, rend = rbase >= 0 ? rbase + 64 : T_TOK;
    f32x4 vn[8]; u32x2 vb[8];
    int row = (rbase >= 0 ? rbase : (int)blockIdx.x * 8) + wid;
    if (row < rend) {
#pragma unroll
        for (int i = 0; i < 8; ++i) { if (DO_LN) vb[i] = *(const u32x2*)(zb + (size_t)row * DM + lane * 4 + i * 256); else vn[i] = *(const f32x4*)(xin + (size_t)row * DM + lane * 4 + i * 256); }
    }
    for (; row < rend; row += rstep) {
        f32x4 v[8], scv[8], shv[8];
#pragma unroll
        for (int i = 0; i < 8; ++i) { if (DO_LN) v[i] = (f32x4){bflo(vb[i].x), bfhi(vb[i].x), bflo(vb[i].y), bfhi(vb[i].y)}; else v[i] = vn[i]; }
        { const int nrow = row + rstep;
          if (nrow < rend) {
#pragma unroll
              for (int i = 0; i < 8; ++i) { if (DO_LN) vb[i] = *(const u32x2*)(zb + (size_t)nrow * DM + lane * 4 + i * 256); else vn[i] = *(const f32x4*)(xin + (size_t)nrow * DM + lane * 4 + i * 256); }
          } }
        if (DO_LN) {
            float s = 0.f;
#pragma unroll
            for (int i = 0; i < 8; ++i) s += (v[i][0] + v[i][1]) + (v[i][2] + v[i][3]);
#pragma unroll
            for (int o = 32; o >= 1; o >>= 1) s += __shfl_xor(s, o);
            const float mu = s * (1.0f / DM);
            float q = 0.f;
#pragma unroll
            for (int i = 0; i < 8; ++i) { v[i] -= mu; q += (v[i][0] * v[i][0] + v[i][1] * v[i][1]) + (v[i][2] * v[i][2] + v[i][3] * v[i][3]); }
#pragma unroll
            for (int o = 32; o >= 1; o >>= 1) q += __shfl_xor(q, o);
            const float rstd = rsqrtf(q * (1.0f / DM) + 1e-5f);
            const unsigned voff = (unsigned)lane * 16u;
            {
                f32x4 gg[8], bb[8];
#pragma unroll
                for (int i = 0; i < 8; ++i) { gg[i] = *(const f32x4*)((const char*)g + (voff + (unsigned)i * 1024u)); bb[i] = *(const f32x4*)((const char*)bta + (voff + (unsigned)i * 1024u)); }
#pragma unroll
                for (int i = 0; i < 8; ++i) v[i] = v[i] * rstd * gg[i] + bb[i];
            }
            if (U) {
                const char* mb = (const char*)(modl + (size_t)(row >> 12) * (6 * DM));
#pragma unroll
                for (int i = 0; i < 8; ++i) { scv[i] = *(const f32x4*)(mb + ((unsigned)sc_off * 4u + voff + (unsigned)i * 1024u)); shv[i] = *(const f32x4*)(mb + ((unsigned)sh_off * 4u + voff + (unsigned)i * 1024u)); }
            }
            if (stats) { if (lane == 0) *(f32x2*)(stats + 2 * row) = (f32x2){mu, rstd}; }
            else {
                float* op = xout + (size_t)row * DM + lane * 4;
#pragma unroll
                for (int i = 0; i < 8; ++i) *(f32x4*)(op + i * 256) = v[i];
            }
        }
        if (U) {
            if (!DO_LN) {
                const unsigned voff = (unsigned)lane * 16u;
                const char* mb = (const char*)(modl + (size_t)(row >> 12) * (6 * DM));
#pragma unroll
                for (int i = 0; i < 8; ++i) { scv[i] = *(const f32x4*)(mb + ((unsigned)sc_off * 4u + voff + (unsigned)i * 1024u)); shv[i] = *(const f32x4*)(mb + ((unsigned)sh_off * 4u + voff + (unsigned)i * 1024u)); }
            }
#pragma unroll
            for (int i = 0; i < 8; ++i) {
                const f32x4 uu = v[i] * (scv[i] + 1.0f) + shv[i];
                u32x2 w; w.x = cvt_pk_bf16(uu[0], uu[1]); w.y = cvt_pk_bf16(uu[2], uu[3]);
                *(u32x2*)(U + pg8::tiled_off(row, i * 256 + lane * 4, DM / 64)) = w;
                if (!DO_LN) { u32x2 wz; wz.x = cvt_pk_bf16(v[i][0], v[i][1]); wz.y = cvt_pk_bf16(v[i][2], v[i][3]); *(u32x2*)(zb + (size_t)row * DM + lane * 4 + i * 256) = wz; }
            }
        }
    }
}

struct AttnStep { size_t tb; int h, dl, r, n, br, first; };
__device__ __forceinline__ AttnStep attn_step(int wg, int q, int mode) {
    AttnStep a;
    if (mode) { const int bh = wg >> 3; a.tb = (size_t)(bh >> 3) * SEQ; a.h = bh & 7; a.br = 0; a.dl = 0; a.r = 0; a.n = 4 * (wg & 7) + q; a.first = (q == 0); }
    else if (wg < 128) { a.tb = (size_t)(wg >> 5) * SEQ; a.h = (wg >> 2) & 7; a.br = 1; a.dl = 2; a.r = wg & 3; a.n = q; a.first = (q == 0); }
    else { const int c16 = (wg - 128) * 4 + (q >> 1); a.tb = (size_t)(c16 >> 7) * SEQ; a.h = (c16 >> 4) & 7; a.br = 2; a.dl = 4; a.r = c16 & 15; a.n = q & 1; a.first = !(q & 1); }
    return a;
}
__device__ __forceinline__ void attn_phase(const Params& p, LAS unsigned char* lds, int l, int mode) {
    const bf16_t* proj = (const bf16_t*)(p.ws + WS_PROJ);
    bf16_t* opart = (bf16_t*)(p.ws + WS_OPART); float* lse = (float*)(p.ws + WS_LSE);
    bf16_t* mixed = (bf16_t*)(p.ws + WS_U);
    const float* gain = p.mix_g + (size_t)l * DM;
    const int tid = opaque_tid(), wid = tid >> 6, lane = tid & 63, li = lane & 15, g = lane >> 4;
    LAS unsigned char* Kl = lds; LAS unsigned char* Vl = lds + 256 * 272;
    constexpr int KH = 128 * 272, VH = 128 * 288;
    const int nsteps = mode ? 4 : 8;
    u32x4 kv[4], vv[4]; bf16x8 qf[4];
#define ATTN_LOAD_BLK(A, NB) do { _Pragma("unroll") for (int i = 0; i < 4; ++i) { const int idx = tid + 512 * i, row = idx >> 4, ch = idx & 15; \
            const bf16_t* src = proj + ((A).tb + ((size_t)((NB) * 128 + row) << (A).dl) + (A).r) * DIN + (A).h * 128 + ch * 8; kv[i] = *(const u32x4*)(src + 1024); vv[i] = *(const u32x4*)(src + 2048); } } while (0)
#define ATTN_STORE_BLK(HH) do { _Pragma("unroll") for (int i = 0; i < 4; ++i) { const int idx = tid + 512 * i, row = idx >> 4, ch = idx & 15; \
            *(LAS u32x4*)(Kl + (HH) * KH + row * 272 + ch * 16) = kv[i]; *(LAS u32x4*)(Vl + (HH) * VH + row * 288 + ch * 16) = vv[i]; } } while (0)
#define ATTN_LOAD_Q(A) do { const size_t qt_ = (A).tb + ((size_t)((A).n * 128 + wid * 16 + li) << (A).dl) + (A).r; \
            _Pragma("unroll") for (int s = 0; s < 4; ++s) qf[s] = *(const bf16x8*)(proj + qt_ * DIN + (A).h * 128 + s * 32 + g * 8); } while (0)
    for (int wg = blockIdx.x; wg < 256; wg += gridDim.x) {
        AttnStep cur = attn_step(wg, 0, mode);
        if (mode && cur.n > 0) { ATTN_LOAD_BLK(cur, cur.n - 1); ATTN_STORE_BLK(1); }
        ATTN_LOAD_BLK(cur, cur.n); ATTN_LOAD_Q(cur);
        for (int q = 0; q < nsteps; ++q) {
            const int c = q & 1;
            if (cur.first && cur.n == 0) {
#pragma unroll
                for (int i = 0; i < 4; ++i) { const int idx = tid + 512 * i, row = idx >> 4, ch = idx & 15;
                    *(LAS u32x4*)(Kl + (c ^ 1) * KH + row * 272 + ch * 16) = (u32x4){0u, 0u, 0u, 0u}; *(LAS u32x4*)(Vl + (c ^ 1) * VH + row * 288 + ch * 16) = (u32x4){0u, 0u, 0u, 0u}; }
            }
            ATTN_STORE_BLK(c);
            bf16x8 qc[4];
#pragma unroll
            for (int s = 0; s < 4; ++s) qc[s] = qf[s];
            asm volatile("s_waitcnt lgkmcnt(0)" ::: "memory"); __builtin_amdgcn_s_barrier(); asm volatile("" ::: "memory");
            AttnStep nxt = attn_step(wg, (q + 1 < nsteps) ? q + 1 : q, mode);
            if (q + 1 < nsteps) { ATTN_LOAD_BLK(nxt, nxt.n); ATTN_LOAD_Q(nxt); }
            const int n = cur.n, dl = cur.dl, h = cur.h, mbase = (n - 1) * 128;
            const int qi = wid * 16 + li; const size_t qtok = cur.tb + ((size_t)(n * 128 + qi) << dl) + cur.r;
            const int kb0 = wid & ~1;
            const int koffP = (c ^ 1) * KH, koffC = c * KH, voffP = (c ^ 1) * VH, voffC = c * VH;
            f32x4 sacc[10];
#pragma unroll
            for (int i = 0; i < 10; ++i) {
                sacc[i] = (f32x4){0.f, 0.f, 0.f, 0.f};
                const int kb = kb0 + i, koff = (kb < 8) ? koffP + kb * (16 * 272) : koffC + (kb - 8) * (16 * 272);
#pragma unroll
                for (int s = 0; s < 4; ++s) {
                    const bf16x8 kf = *(const LAS bf16x8*)(Kl + koff + li * 272 + (32 * s + 8 * g) * 2);
                    sacc[i] = __builtin_amdgcn_mfma_f32_16x16x32_bf16(kf, qc[s], sacc[i], 0, 0, 0);
                }
            }
            float mx = -1e30f;
#pragma unroll
            for (int i = 0; i < 10; ++i)
#pragma unroll
                for (int j = 0; j < 4; ++j) {
                    const int kj = 16 * (kb0 + i) + 4 * g + j, dist = 128 + qi - kj;
                    const bool valid = (dist >= 0) && (dist <= 128) && (mbase + kj >= 0);
                    const float sv = valid ? sacc[i][j] : -1e30f;
                    sacc[i][j] = sv; mx = fmaxf(mx, sv);
                }
            mx = fmaxf(mx, __shfl_xor(mx, 16)); mx = fmaxf(mx, __shfl_xor(mx, 32));
            float lsum = 0.f;
#pragma unroll
            for (int i = 0; i < 10; ++i)
#pragma unroll
                for (int j = 0; j < 4; ++j) { const float pv = __builtin_amdgcn_exp2f(sacc[i][j] - mx); sacc[i][j] = pv; lsum += pv; }
            lsum += __shfl_xor(lsum, 16); lsum += __shfl_xor(lsum, 32);
            u32x2 x1[8], x2[8]; float l1 = 0.f, l2 = 0.f;
            if (mode) {
                l1 = lse[qtok * 8 + h]; l2 = lse[((size_t)T_TOK + qtok) * 8 + h];
                const bf16_t* p1 = opart + qtok * 1024 + h * 128 + 4 * g; const bf16_t* p2 = p1 + (size_t)T_TOK * 1024;
#pragma unroll
                for (int db = 0; db < 8; ++db) { x1[db] = *(const u32x2*)(p1 + 16 * db); x2[db] = *(const u32x2*)(p2 + 16 * db); }
            }
            f32x4 oacc[8];
#pragma unroll
            for (int db = 0; db < 8; ++db) oacc[db] = (f32x4){0.f, 0.f, 0.f, 0.f};
            const int vlane = (4 * g + (li >> 2)) * 288 + (4 * (li & 3)) * 2;
#pragma unroll
            for (int t = 0; t < 5; ++t) {
                u32x4 pw; pw.x = cvt_pk_bf16(sacc[2 * t][0], sacc[2 * t][1]); pw.y = cvt_pk_bf16(sacc[2 * t][2], sacc[2 * t][3]);
                pw.z = cvt_pk_bf16(sacc[2 * t + 1][0], sacc[2 * t + 1][1]); pw.w = cvt_pk_bf16(sacc[2 * t + 1][2], sacc[2 * t + 1][3]);
                const bf16x8 pf = __builtin_bit_cast(bf16x8, pw);
                const int kbv = kb0 + 2 * t, voff = (kbv < 8) ? voffP + kbv * (16 * 288) : voffC + (kbv - 8) * (16 * 288);
                const LAS unsigned char* vb = Vl + voff + vlane;
#pragma unroll
                for (int db = 0; db < 8; ++db) {
                    const s16x4 lo = __builtin_bit_cast(s16x4, __builtin_amdgcn_ds_read_tr16_b64_v4i16((LAS s16x4*)(vb + db * 32)));
                    const s16x4 hi = __builtin_bit_cast(s16x4, __builtin_amdgcn_ds_read_tr16_b64_v4i16((LAS s16x4*)(vb + 16 * 288 + db * 32)));
                    const bf16x8 vf = __builtin_shufflevector(lo, hi, 0, 1, 2, 3, 4, 5, 6, 7);
                    oacc[db] = __builtin_amdgcn_mfma_f32_16x16x32_bf16(vf, pf, oacc[db], 0, 0, 0);
                }
            }
            const float inv = 1.0f / lsum, lse0 = mx + __builtin_amdgcn_logf(lsum);
            if (mode == 0) {
                bf16_t* op = opart + ((size_t)(cur.br - 1) * T_TOK + qtok) * 1024 + h * 128 + 4 * g;
#pragma unroll
                for (int db = 0; db < 8; ++db) { const f32x4 o = oacc[db] * inv; u32x2 w; w.x = cvt_pk_bf16(o[0], o[1]); w.y = cvt_pk_bf16(o[2], o[3]); *(u32x2*)(op + 16 * db) = w; }
                if (g == 0) lse[((size_t)(cur.br - 1) * T_TOK + qtok) * 8 + h] = lse0;
            } else {
                const float lm = fmaxf(lse0, fmaxf(l1, l2));
                const float w0 = __builtin_amdgcn_exp2f(lse0 - lm), w1 = __builtin_amdgcn_exp2f(l1 - lm), w2 = __builtin_amdgcn_exp2f(l2 - lm);
                const float wi = 1.0f / (w0 + w1 + w2), a0 = w0 * wi * inv, a1 = w1 * wi, a2 = w2 * wi;
                float ss = 0.f;
#pragma unroll
                for (int db = 0; db < 8; ++db) {
                    f32x4 o = oacc[db] * a0;
                    o[0] += bflo(x1[db].x) * a1 + bflo(x2[db].x) * a2; o[1] += bfhi(x1[db].x) * a1 + bfhi(x2[db].x) * a2;
                    o[2] += bflo(x1[db].y) * a1 + bflo(x2[db].y) * a2; o[3] += bfhi(x1[db].y) * a1 + bfhi(x2[db].y) * a2;
                    oacc[db] = o; ss += (o[0] * o[0] + o[1] * o[1]) + (o[2] * o[2] + o[3] * o[3]);
                }
                ss += __shfl_xor(ss, 16); ss += __shfl_xor(ss, 32);
                const float rs = rsqrtf(ss * (1.0f / 128.0f) + 1e-6f);
                f32x4 ggv[8];
#pragma unroll
                for (int db = 0; db < 8; ++db) ggv[db] = *(const f32x4*)(gain + h * 128 + 16 * db + 4 * g);
#pragma unroll
                for (int db = 0; db < 8; ++db) {
                    const f32x4 gg = ggv[db];
                    const f32x4 o = oacc[db] * rs * gg;
                    u32x2 w; w.x = cvt_pk_bf16(o[0], o[1]); w.y = cvt_pk_bf16(o[2], o[3]);
                    *(u32x2*)(mixed + pg8::tiled_off((int)qtok, h * 128 + 16 * db + 4 * g, DM / 64)) = w;
                }
            }
            asm volatile("s_waitcnt lgkmcnt(0)" ::: "memory"); __builtin_amdgcn_s_barrier(); asm volatile("" ::: "memory");
            cur = nxt;
        }
    }
#undef ATTN_LOAD_BLK
#undef ATTN_STORE_BLK
#undef ATTN_LOAD_Q
}

__device__ __forceinline__ void conv_phase(const Params& p, int l) {
    const bf16_t* proj = (const bf16_t*)(p.ws + WS_PROJ);
    bf16_t* mixed = (bf16_t*)(p.ws + WS_U);
    const float* gain = p.mix_g + (size_t)l * DM; const float* cw = p.conv_w + (size_t)l * 3 * 1024;
    const int tid = opaque_tid(), wid = tid >> 6, lane = tid & 63;
    u32x2 ngb[4], ngc0[4], nhi0[4], ngc1[4], nhi1[4], ngc2[4], nhi2[4];
#define CONV_LOAD(T) do { const int pos_ = (T) & (SEQ - 1); _Pragma("unroll") for (int i = 0; i < 4; ++i) { \
            const bf16_t* pr = proj + (size_t)(T) * DIN + i * 256 + lane * 4; \
            ngb[i] = *(const u32x2*)(pr + 3072); ngc0[i] = *(const u32x2*)(pr + 4096); nhi0[i] = *(const u32x2*)(pr + 5120); \
            ngc1[i] = (u32x2){0u, 0u}; nhi1[i] = ngc1[i]; ngc2[i] = ngc1[i]; nhi2[i] = ngc1[i]; \
            if (pos_ >= 1) { ngc1[i] = *(const u32x2*)(pr - DIN + 4096); nhi1[i] = *(const u32x2*)(pr - DIN + 5120); } \
            if (pos_ >= 2) { ngc2[i] = *(const u32x2*)(pr - 2 * DIN + 4096); nhi2[i] = *(const u32x2*)(pr - 2 * DIN + 5120); } } } while (0)
    int t = blockIdx.x * 8 + wid;
    if (t < T_TOK) CONV_LOAD(t);
    for (; t < T_TOK; t += gridDim.x * 8) {
        u32x2 gb[4], gc0[4], hi0[4], gc1[4], hi1[4], gc2[4], hi2[4];
#pragma unroll
        for (int i = 0; i < 4; ++i) { gb[i] = ngb[i]; gc0[i] = ngc0[i]; hi0[i] = nhi0[i]; gc1[i] = ngc1[i]; hi1[i] = nhi1[i]; gc2[i] = ngc2[i]; hi2[i] = nhi2[i]; }
        { const int tn = t + gridDim.x * 8; if (tn < T_TOK) CONV_LOAD(tn); }
        f32x4 cw0[4], cw1[4], cw2[4], g2[4];
#pragma unroll
        for (int i = 0; i < 4; ++i) { const int col = i * 256 + lane * 4;
            cw0[i] = *(const f32x4*)(cw + col); cw1[i] = *(const f32x4*)(cw + 1024 + col); cw2[i] = *(const f32x4*)(cw + 2048 + col); g2[i] = *(const f32x4*)(gain + 1024 + col); }
#pragma unroll
        for (int i = 0; i < 4; ++i) {
            const int col = i * 256 + lane * 4;
            f32x4 c0, c1, c2, gbv;
            c0[0] = bflo(gc0[i].x) * bflo(hi0[i].x); c0[1] = bfhi(gc0[i].x) * bfhi(hi0[i].x); c0[2] = bflo(gc0[i].y) * bflo(hi0[i].y); c0[3] = bfhi(gc0[i].y) * bfhi(hi0[i].y);
            c1[0] = bflo(gc1[i].x) * bflo(hi1[i].x); c1[1] = bfhi(gc1[i].x) * bfhi(hi1[i].x); c1[2] = bflo(gc1[i].y) * bflo(hi1[i].y); c1[3] = bfhi(gc1[i].y) * bfhi(hi1[i].y);
            c2[0] = bflo(gc2[i].x) * bflo(hi2[i].x); c2[1] = bfhi(gc2[i].x) * bfhi(hi2[i].x); c2[2] = bflo(gc2[i].y) * bflo(hi2[i].y); c2[3] = bfhi(gc2[i].y) * bfhi(hi2[i].y);
            gbv[0] = bflo(gb[i].x); gbv[1] = bfhi(gb[i].x); gbv[2] = bflo(gb[i].y); gbv[3] = bfhi(gb[i].y);
            f32x4 y = gbv * (cw0[i] * c2 + cw1[i] * c1 + cw2[i] * c0);
            float s2 = (y[0] * y[0] + y[1] * y[1]) + (y[2] * y[2] + y[3] * y[3]);
#pragma unroll
            for (int sft = 16; sft >= 1; sft >>= 1) s2 += __shfl_xor(s2, sft);
            const float rs2 = rsqrtf(s2 * (1.0f / 128.0f) + 1e-6f);
            y = y * rs2 * g2[i];
            u32x2 wy; wy.x = cvt_pk_bf16(y[0], y[1]); wy.y = cvt_pk_bf16(y[2], y[3]);
            *(u32x2*)(mixed + pg8::tiled_off(t, 1024 + col, DM / 64)) = wy;
        }
    }
#undef CONV_LOAD
}

#define XB_TMO      128
#define XB_XCNT(j)  (256  + 64 * (j))
#define XB_XSUB(j)  (1280 + 64 * (j))
#define XB_XGEN(j)  (2304 + 64 * (j))
#define XB_TOP      3328
#define XB_TOPGEN   3392
#define XB_LSUB(j)  (3456 + 64 * (j))
#define XB_LGEN(j)  (3968 + 64 * (j))
#define XCD_BAR_WORDS 4480
#define XB_SPIN_CAP (1u << 22)
__device__ __forceinline__ unsigned xb_ld(unsigned* p)              { return __hip_atomic_load(p, __ATOMIC_RELAXED, __HIP_MEMORY_SCOPE_AGENT); }
__device__ __forceinline__ unsigned xb_add(unsigned* p, unsigned v) { return __hip_atomic_fetch_add(p, v, __ATOMIC_RELAXED, __HIP_MEMORY_SCOPE_AGENT); }
#define XB_SPIN(cond, bar) do { unsigned _sp = 0; while (cond) { __builtin_amdgcn_s_sleep(1); \
    if ((++_sp & 255u) == 0u) { if (xb_ld(&(bar)[XB_TMO])) break; if (_sp > XB_SPIN_CAP) { atomicAdd(&(bar)[XB_TMO], 1u); break; } } } } while (0)
struct XcdBarrier { unsigned* bar; unsigned x; volatile LAS unsigned* st; };
__device__ __forceinline__ void xcd_barrier_complete(unsigned* bar, unsigned x, unsigned& nloc, unsigned& nx) {
    const unsigned G = gridDim.x * gridDim.y * gridDim.z;
    unsigned sum, cnt, mine, sp = 0u;
    for (;;) {
        sum = 0u; cnt = 0u; mine = 0u;
#pragma unroll
        for (unsigned j = 0; j < 16; ++j) { const unsigned c = xb_ld(&bar[XB_XCNT(j)]); sum += c; cnt += (c > 0u) ? 1u : 0u; mine = (j == x) ? c : mine; }
        if (sum == G) break;
        __builtin_amdgcn_s_sleep(1);
        if ((++sp & 255u) == 0u) { if (xb_ld(&bar[XB_TMO])) break; if (sp > XB_SPIN_CAP) { atomicAdd(&bar[XB_TMO], 1u); break; } }
    }
    nloc = mine > 0u ? mine : 1u; nx = cnt > 0u ? cnt : 1u;
}
__device__ __forceinline__ void xcd_barrier(const XcdBarrier& b) {
    asm volatile("s_waitcnt vmcnt(0)" ::: "memory");
    __syncthreads();
    if (threadIdx.x == 0) {
        unsigned* bar = b.bar;
        __builtin_amdgcn_s_waitcnt(0);
        unsigned nloc = b.st[0], nx = b.st[1];
        if (nloc == 0u) { xcd_barrier_complete(bar, b.x, nloc, nx); b.st[0] = nloc; b.st[1] = nx; }
        const unsigned old = xb_add(&bar[XB_XSUB(b.x)], 1u);
        const unsigned gen = old / nloc;
        if (old + 1u == (gen + 1u) * nloc) {
            __builtin_amdgcn_fence(__ATOMIC_RELEASE, "agent");
            asm volatile("s_waitcnt vmcnt(0)" ::: "memory");
            const unsigned og = xb_add(&bar[XB_TOP], 1u);
            const unsigned tg = og / nx;
            if (og + 1u == (tg + 1u) * nx) xb_add(&bar[XB_TOPGEN], 1u);
            else XB_SPIN(xb_ld(&bar[XB_TOPGEN]) == tg, bar);
            __builtin_amdgcn_fence(__ATOMIC_ACQUIRE, "agent");
            xb_add(&bar[XB_XGEN(b.x)], 1u);
            asm volatile("s_waitcnt vmcnt(0)" ::: "memory");
        } else {
            XB_SPIN(xb_ld(&bar[XB_XGEN(b.x)]) == gen, bar);
            __builtin_amdgcn_fence(__ATOMIC_ACQUIRE, "agent");
            asm volatile("s_waitcnt vmcnt(0)" ::: "memory");
        }
    }
    __syncthreads();
}

__device__ __forceinline__ void xcd_local_barrier(const XcdBarrier& b, unsigned nloc) {
    asm volatile("s_waitcnt vmcnt(0)" ::: "memory");
    __syncthreads();
    if (threadIdx.x == 0) {
        unsigned* bar = b.bar;
        __builtin_amdgcn_s_waitcnt(0);
        const unsigned old = xb_add(&bar[XB_LSUB(b.x)], 1u);
        const unsigned gen = old / nloc;
        if (old + 1u == (gen + 1u) * nloc) xb_add(&bar[XB_LGEN(b.x)], 1u);
        else XB_SPIN(xb_ld(&bar[XB_LGEN(b.x)]) == gen, bar);
        __builtin_amdgcn_fence(__ATOMIC_ACQUIRE, "agent");
        asm volatile("s_waitcnt vmcnt(0)" ::: "memory");
    }
    __syncthreads();
}

__global__ void __launch_bounds__(512, 2) fwd_megakernel(Params p) {
    extern __shared__ __attribute__((aligned(16))) unsigned char shm[];
    LAS unsigned char* lds = (LAS unsigned char*)shm;
    const float* mod = (const float*)(p.ws + WS_MOD);
    bf16_t* zb = (bf16_t*)(p.ws + WS_ZB);
    int vc = blockIdx.x, myrank = 0; bool xlocal = false;
    unsigned* bar = (unsigned*)(p.ws + WS_CTL);
    XcdBarrier xb; xb.bar = bar; xb.x = (unsigned)__builtin_amdgcn_s_getreg((3 << 11) | 20) & 0xFu; xb.st = (volatile LAS unsigned*)(lds + LDS_ST);
    const bool fused = (p.ph_hi - p.ph_lo) > 1;
    if (p.never) cg::this_grid().sync();
    if (fused) {
        if (threadIdx.x == 0) { xb.st[0] = 0u; xb.st[1] = 0u; xb.st[2] = xb_add(&bar[XB_XCNT(xb.x)], 1u); }
        __syncthreads();
        myrank = (int)xb.st[2];
    }
    for (int ph = p.ph_lo; ph < p.ph_hi; ++ph) {
        if (ph > p.ph_lo) {
            const int sb = (ph - 2) & 7;
            if (ph >= 2 && xlocal && sb >= 4) xcd_local_barrier(xb, gridDim.x / 8); else xcd_barrier(xb);
        }
        if (ph == 1 && fused) {
            unsigned cc[16];
#pragma unroll
            for (int i = 0; i < 16; ++i) cc[i] = xb_ld(&bar[XB_XCNT(i)]);
            unsigned bad = gridDim.x & 7u;
#pragma unroll
            for (int i = 0; i < 16; ++i) bad |= cc[i] ^ (i < 8 ? gridDim.x / 8 : 0u);
            if (bad == 0u) { vc = myrank * 8 + (int)xb.x; xlocal = gridDim.x == 256; }
        }
        if (ph == 0) { pro_a_phase(p, lds); continue; }
        if (ph == 1) { row_phase<false>(p.x, zb, nullptr, nullptr, nullptr, mod, 1 * DM, 0, (bf16_t*)(p.ws + WS_U), nullptr, -1); continue; }
        const int l = (ph - 2) >> 3, s = (ph - 2) & 7;
        const float* modl = mod + (size_t)l * 4 * 6 * DM;
        float* stats = (float*)(p.ws + WS_STATS);
        const int rown = gridDim.x == 256 ? (vc & 7) * 2048 + (vc >> 3) * 64 : -1;
        pg8::StaticOrder S;
        if (s == 0) {
            pg8::Gemm g{(const bf16_t*)(p.ws + WS_U), (const bf16_t*)(p.ws + WS_WT_IN) + (size_t)l * DIN * LDU, T_TOK, DIN, DM, LDU, LDU};
            S.init(g.M, g.N, gridDim.x, vc);
            pg8::EpiProj E{(bf16_t*)(p.ws + WS_PROJ), (const float*)(p.ws + WS_COS), (const float*)(p.ws + WS_SIN)};
            pg8::gemm_phase<pg8::EpiProj>(lds, g, S, E);
        } else if (s == 1) {
            attn_phase(p, lds, l, 0); conv_phase(p, l);
        } else if (s == 2) {
            attn_phase(p, lds, l, 1);
        } else if (s == 3 || s == 6) {
            pg8::Gemm g; pg8::EpiRes E;
            if (s == 3) { g = pg8::Gemm{(const bf16_t*)(p.ws + WS_U), (const bf16_t*)(p.ws + WS_WT_OUT) + (size_t)l * DM * LDU, T_TOK, DM, DM, LDU, LDU};
                          E = pg8::EpiRes{zb, modl + 2 * DM, l == 0 ? nullptr : stats, p.ln2_g + (size_t)(l - (l > 0)) * DM, p.ln2_b + (size_t)(l - (l > 0)) * DM}; }
            else        { g = pg8::Gemm{(const bf16_t*)(p.ws + WS_H), (const bf16_t*)(p.ws + WS_WT_FF2) + (size_t)l * DM * LDH, T_TOK, DM, DFF, LDH, LDH};
                          E = pg8::EpiRes{zb, modl + 5 * DM, stats, p.ln1_g + (size_t)l * DM, p.ln1_b + (size_t)l * DM}; }
            S.init(g.M, g.N, gridDim.x, vc);
            pg8::gemm_phase<pg8::EpiRes>(lds, g, S, E);
        } else if (s == 4 || s == 7) {
            if (s == 4) row_phase<true>(nullptr, zb, p.out, p.ln1_g + (size_t)l * DM, p.ln1_b + (size_t)l * DM, modl, 4 * DM, 3 * DM, (bf16_t*)(p.ws + WS_U), stats, rown);
            else        row_phase<true>(nullptr, zb, p.out, p.ln2_g + (size_t)l * DM, p.ln2_b + (size_t)l * DM, modl + (size_t)4 * 6 * DM, 1 * DM, 0, (l + 1 < NLAYER) ? (bf16_t*)(p.ws + WS_U) : nullptr, (l + 1 < NLAYER) ? stats : nullptr, rown);
        } else {
            pg8::Gemm g{(const bf16_t*)(p.ws + WS_U), (const bf16_t*)(p.ws + WS_WT_FF1) + (size_t)l * DFF * LDU, T_TOK, DFF, DM, LDU, LDU};
            S.init(g.M, g.N, gridDim.x, vc);
            pg8::EpiFF1 E{(bf16_t*)(p.ws + WS_H)};
            pg8::gemm_phase<pg8::EpiFF1>(lds, g, S, E);
        }
    }
}

constexpr int N_PHASES = 2 + 8 * NLAYER;

extern "C" void kernel_launch(void* const* d_in, const int* in_sizes, int n_in, void* d_out, int out_size, void* d_ws, size_t ws_size, hipStream_t stream) {
    static int grid = 0;
    if (grid == 0) {
        int dev = 0, cus = 0, per_cu = 0;
        (void)hipGetDevice(&dev);
        (void)hipDeviceGetAttribute(&cus, hipDeviceAttributeMultiprocessorCount, dev);
        if (hipFuncSetAttribute((const void*)fwd_megakernel, hipFuncAttributeMaxDynamicSharedMemorySize, LDS_BYTES) != hipSuccess) fprintf(stderr, "hipFuncSetAttribute failed\n");
        if (hipOccupancyMaxActiveBlocksPerMultiprocessor(&per_cu, (const void*)fwd_megakernel, 512, LDS_BYTES) != hipSuccess || per_cu < 1) per_cu = 1;
        (void)hipGetLastError();
        grid = cus * per_cu;
        if (ws_size < WS_END) fprintf(stderr, "workspace too small: %zu < %zu\n", ws_size, (size_t)WS_END);
    }
    Params p{};
    p.x = (const float*)d_in[0]; p.c = (const float*)d_in[1]; p.w_in = (const float*)d_in[2]; p.conv_w = (const float*)d_in[3]; p.mix_g = (const float*)d_in[4];
    p.w_out = (const float*)d_in[5]; p.w_mod = (const float*)d_in[6]; p.b_mod = (const float*)d_in[7]; p.ln1_g = (const float*)d_in[8]; p.ln1_b = (const float*)d_in[9];
    p.w_ff1 = (const float*)d_in[10]; p.w_ff2 = (const float*)d_in[11]; p.ln2_g = (const float*)d_in[12]; p.ln2_b = (const float*)d_in[13];
    p.out = (float*)d_out; p.ws = (unsigned char*)d_ws;
#if SINGLE_LAUNCH
    (void)hipMemsetAsync((unsigned char*)d_ws + WS_CTL, 0, 20480, stream);
    p.ph_lo = 0; p.ph_hi = N_PHASES;
    void* args[] = {&p};
    hipError_t e = hipLaunchCooperativeKernel((const void*)fwd_megakernel, dim3(grid), dim3(512), args, LDS_BYTES, stream);
    if (e != hipSuccess) fprintf(stderr, "cooperative launch failed: %s (grid %d)\n", hipGetErrorString(e), grid);
#else
    for (int ph = 0; ph < N_PHASES; ++ph) {
        p.ph_lo = ph; p.ph_hi = ph + 1;
        hipLaunchKernelGGL(fwd_megakernel, dim3(grid), dim3(512), LDS_BYTES, stream, p);
    }
#endif
}
```

```cpp
#include <hip/hip_runtime.h>
#include <hip/hip_cooperative_groups.h>
#include <cstdio>
namespace cg = cooperative_groups;

#ifndef SINGLE_LAUNCH
#define SINGLE_LAUNCH 1
#endif

#define LAS __attribute__((address_space(3)))
typedef unsigned short bf16_t;
typedef short bf16x8 __attribute__((ext_vector_type(8)));
typedef short s16x4 __attribute__((ext_vector_type(4)));
typedef float f32x4 __attribute__((ext_vector_type(4)));
typedef float f32x2 __attribute__((ext_vector_type(2)));
typedef unsigned u32x4 __attribute__((ext_vector_type(4)));
typedef unsigned u32x2 __attribute__((ext_vector_type(2)));

constexpr int T_TOK = 16384, SEQ = 4096, DM = 2048, DIN = 6144, DFF = 8192, NLAYER = 2;
constexpr int KPAD = 0, LDU = DM + KPAD, LDH = DFF + KPAD;
constexpr float ALPHA = 1.4142135623730951f;
constexpr float QSCALE = 0.08838834764831845f * 1.4426950408889634f;

constexpr size_t WS_WT_IN = 0;
constexpr size_t WS_WT_OUT = WS_WT_IN + (size_t)NLAYER * DIN * LDU * 2;
constexpr size_t WS_WT_FF1 = WS_WT_OUT + (size_t)NLAYER * DM * LDU * 2;
constexpr size_t WS_WT_FF2 = WS_WT_FF1 + (size_t)NLAYER * DFF * LDU * 2;
constexpr size_t WS_MOD = WS_WT_FF2 + (size_t)NLAYER * DM * LDH * 2;
constexpr size_t WS_COS = WS_MOD + (size_t)NLAYER * 4 * 6 * DM * 4;
constexpr size_t WS_SIN = WS_COS + (size_t)SEQ * 64 * 4;
constexpr size_t WS_U = WS_SIN + (size_t)SEQ * 64 * 4;
constexpr size_t WS_PROJ = WS_U + (size_t)T_TOK * LDU * 2;
constexpr size_t WS_OPART = WS_PROJ + (size_t)T_TOK * DIN * 2;
constexpr size_t WS_LSE = WS_OPART + (size_t)3 * T_TOK * 1024 * 4;
constexpr size_t WS_CTL = WS_LSE + (size_t)3 * T_TOK * 8 * 4;
constexpr size_t WS_STATS = WS_CTL + 20480;
constexpr size_t WS_END = WS_STATS + (size_t)T_TOK * 2 * 4;
constexpr size_t WS_ZB = WS_OPART + (size_t)2 * T_TOK * 1024 * 2;
constexpr size_t WS_H = WS_PROJ;

constexpr int LDS_ST = 256 * 272 + 256 * 288;
constexpr int LDS_BYTES = LDS_ST + 16;

struct Params {
    const float* x; const float* c; const float* w_in; const float* conv_w; const float* mix_g; const float* w_out;
    const float* w_mod; const float* b_mod; const float* ln1_g; const float* ln1_b; const float* w_ff1; const float* w_ff2;
    const float* ln2_g; const float* ln2_b;
    float* out; unsigned char* ws;
    int ph_lo, ph_hi, never, pad;
};

__device__ __forceinline__ unsigned cvt_pk_bf16(float lo, float hi) { unsigned r; asm volatile("v_cvt_pk_bf16_f32 %0, %1, %2" : "=v"(r) : "v"(lo), "v"(hi)); return r; }
__device__ __forceinline__ int opaque_tid() { int t = threadIdx.x; asm volatile("" : "+v"(t)); return t; }
__device__ __forceinline__ float bf2f(unsigned short b) { return __uint_as_float(((unsigned)b) << 16); }
__device__ __forceinline__ float bflo(unsigned w) { return __uint_as_float(w << 16); }
__device__ __forceinline__ float bfhi(unsigned w) { return __uint_as_float(w & 0xffff0000u); }

namespace pg8 {
constexpr int BM = 256, BK = 64, HALF = 128, HTB = HALF * BK * 2, STAGE_BYTES = 8 * HTB, NXCD = 8, WGM = 8;
__device__ __forceinline__ int lds_byte(int r, int c) { const int st = (r >> 4) * 2 + (c >> 5), rr = r & 15, cc = c & 31, ob = rr * 64 + cc * 2; return st * 1024 + (ob ^ (((ob >> 9) & 1) << 5)); }
__device__ __forceinline__ void stage_rc(int b, int& R, int& C) { const int st = b / 1024, sb = b % 1024, swz = sb ^ (((sb >> 9) & 1) << 5); R = (st >> 1) * 16 + swz / 64; C = (st & 1) * 32 + (swz % 64) / 2; }
__device__ __forceinline__ int perm32(int rho) { const int n = rho >> 4, i = rho & 15; return 8 * (i >> 2) + 4 * n + (i & 3); }
__device__ __forceinline__ int bperm(int mode, int R) {
    if (mode == 1) return (R & ~31) + perm32(R & 31);
    if (mode == 2) return 64 * ((R >> 4) & 1) + 16 * (R >> 5) + (R & 15);
    return R;
}
__device__ __forceinline__ int bperm_inv(int mode, int s) {
    if (mode == 1) { const int t = s & 31; return (s & ~31) + 16 * ((t >> 2) & 1) + 4 * (t >> 3) + (t & 3); }
    if (mode == 2) return 32 * ((s >> 4) & 3) + 16 * (s >> 6) + (s & 15);
    return s;
}
__device__ __forceinline__ size_t tiled_off(int row, int k, int nkt) {
    return ((size_t)((row >> 7) * nkt + (k >> 6)) << 13) + (size_t)(lds_byte(row & 127, k & 63) >> 1);
}
struct Unit { int pm, pn; };
struct Gemm { const bf16_t* A; const bf16_t* Bt; int M, N, K, lda, ldb; };
struct StaticOrder {
    int nM, nN, nwg, G, c;
    __device__ void init(int M, int N, int G_, int c_) { nM = M / BM; nN = N / BM; nwg = nM * nN; G = G_; c = c_; }
    __device__ bool next(int i, Unit& u) const {
        const long L = (long)i * G + c; if (L >= nwg) return false;
        int wgid = (int)L; { const int q = nwg / NXCD, r = nwg % NXCD, xcd = wgid % NXCD, off = wgid / NXCD; wgid = (xcd < r ? xcd * (q + 1) : r * (q + 1) + (xcd - r) * q) + off; }
        const int nig = WGM * nN, gid = wgid / nig, fm = gid * WGM, gsz = (nM - fm) < WGM ? (nM - fm) : WGM;
        u.pm = fm + ((wgid % nig) % gsz); u.pn = (wgid % nig) / gsz; return true;
    }
};

template <class Epi>
__device__ __forceinline__ void gemm_phase(LAS unsigned char* lds, const Gemm g, const StaticOrder& S, const Epi& E) {
    const int tid = opaque_tid(), wid = __builtin_amdgcn_readfirstlane(tid >> 6), lane = tid & 63, wr = wid >> 2, wc = wid & 3, fr = lane & 15, fq = lane >> 4;
    const int K = g.K, nt = K / BK;
    unsigned voffA[2], voffB[2];
#pragma unroll
    for (int i = 0; i < 2; ++i) { voffA[i] = (unsigned)(tid * 16 + i * 8192); voffB[i] = voffA[i]; }
    const size_t kstep = (size_t)HTB;
    const size_t hstepA = (size_t)nt * HTB, hstepB = hstepA;
    const size_t tstepA = 2 * hstepA, tstepB = tstepA;
    const unsigned ldsw = (unsigned)wid * 1024u;
    const int aoff = lds_byte(wr * 64 + fr, fq * 8), boff = lds_byte(wc * 32 + fr, fq * 8);
#define PG8_SA(b, h) (((b) * 2 + (h)) * HTB)
#define PG8_SB(b, h) ((4 + (b) * 2 + (h)) * HTB)
#define PG8_STAGE(bufoff, gbase, voff) do { _Pragma("unroll") for (int _i = 0; _i < 2; ++_i) \
        __builtin_amdgcn_global_load_lds((const unsigned*)((const char*)(gbase) + (voff)[_i]), (LAS unsigned*)(lds + (bufoff) + ldsw + _i * 8192), 16, 0, 0); } while (0)
#define PG8_LDA(dst, b, h) do { _Pragma("unroll") for (int m = 0; m < 4; ++m) _Pragma("unroll") for (int k = 0; k < 2; ++k) dst[m][k] = *(const LAS bf16x8*)(lds + PG8_SA(b, h) + aoff + m * 2048 + k * 1024); } while (0)
#define PG8_LDB(dst, b, h) do { _Pragma("unroll") for (int n = 0; n < 2; ++n) _Pragma("unroll") for (int k = 0; k < 2; ++k) dst[n][k] = *(const LAS bf16x8*)(lds + PG8_SB(b, h) + boff + n * 2048 + k * 1024); } while (0)
#define PG8_MMA(ai, bj, At, Bt) do { __builtin_amdgcn_s_setprio(1); _Pragma("unroll") for (int m = 0; m < 4; ++m) _Pragma("unroll") for (int n = 0; n < 2; ++n) _Pragma("unroll") for (int k = 0; k < 2; ++k) \
        acc[ai][bj][m][n] = __builtin_amdgcn_mfma_f32_16x16x32_bf16(Bt[n][k], At[m][k], acc[ai][bj][m][n], 0, 0, 0); __builtin_amdgcn_s_setprio(0); } while (0)
#define PG8_WAIT_V(n) asm volatile("s_waitcnt vmcnt(" #n ")" ::: "memory")
#define PG8_WAIT_L(n) asm volatile("s_waitcnt lgkmcnt(" #n ")" ::: "memory")
#define PG8_BAR __builtin_amdgcn_s_barrier()
#define PG8_SCHED __builtin_amdgcn_sched_barrier(0)
    Unit cur, nxt; int ui = 0;
    if (!S.next(0, cur)) return;
    f32x4 acc[2][2][4][2];
#pragma unroll
    for (int a = 0; a < 2; ++a)
#pragma unroll
        for (int b = 0; b < 2; ++b)
#pragma unroll
            for (int m = 0; m < 4; ++m)
#pragma unroll
                for (int n = 0; n < 2; ++n) acc[a][b][m][n] = (f32x4){0.f, 0.f, 0.f, 0.f};
    bf16x8 At[4][2], B0[2][2], B1[2][2];
    const char* cA = (const char*)g.A + (size_t)cur.pm * tstepA; const char* cB = (const char*)g.Bt + (size_t)cur.pn * tstepB;
    PG8_STAGE(PG8_SB(0, 0), cB, voffB); PG8_STAGE(PG8_SA(0, 0), cA, voffA); PG8_STAGE(PG8_SB(0, 1), cB + hstepB, voffB); PG8_STAGE(PG8_SA(0, 1), cA + hstepA, voffA);
    if (wr == 1) PG8_BAR;
    PG8_WAIT_V(4); PG8_BAR;
    PG8_STAGE(PG8_SB(1, 0), cB + kstep, voffB); PG8_STAGE(PG8_SA(1, 0), cA + kstep, voffA); PG8_STAGE(PG8_SB(1, 1), cB + hstepB + kstep, voffB);
    PG8_WAIT_V(6); PG8_BAR;
    for (;;) {
        const bool has_next = S.next(ui + 1, nxt);
        const char* nA = has_next ? (const char*)g.A + (size_t)nxt.pm * tstepA : cA; const char* nB = has_next ? (const char*)g.Bt + (size_t)nxt.pn * tstepB : cB;
        for (int t = 0; t < nt; t += 2) {
            const bool last = (t == nt - 2);
            const char* a1 = cA + (size_t)(t + 1) * kstep;
            const char* a2 = last ? nA : cA + (size_t)(t + 2) * kstep; const char* b2 = last ? nB : cB + (size_t)(t + 2) * kstep;
            const char* a3 = a2 + kstep; const char* b3 = b2 + kstep;
            PG8_LDB(B0, 0, 0); PG8_SCHED; PG8_LDA(At, 0, 0); PG8_STAGE(PG8_SA(1, 1), a1 + hstepA, voffA);
            PG8_WAIT_L(8); PG8_BAR; PG8_WAIT_L(0); PG8_MMA(0, 0, At, B0); PG8_BAR; PG8_SCHED;
            PG8_LDB(B1, 0, 1); PG8_STAGE(PG8_SB(0, 0), b2, voffB);
            PG8_BAR; PG8_WAIT_L(0); PG8_MMA(0, 1, At, B1); PG8_BAR;
            PG8_LDA(At, 0, 1); PG8_STAGE(PG8_SA(0, 0), a2, voffA);
            PG8_BAR; PG8_WAIT_L(0); PG8_MMA(1, 0, At, B0); PG8_BAR; PG8_SCHED;
            PG8_STAGE(PG8_SB(0, 1), b2 + hstepB, voffB);
            PG8_WAIT_V(6); PG8_BAR; PG8_MMA(1, 1, At, B1); PG8_BAR;
            PG8_LDB(B0, 1, 0); PG8_SCHED; PG8_LDA(At, 1, 0); PG8_STAGE(PG8_SA(0, 1), a2 + hstepA, voffA);
            PG8_WAIT_L(8); PG8_BAR; PG8_WAIT_L(0); PG8_MMA(0, 0, At, B0); PG8_BAR; PG8_SCHED;
            PG8_LDB(B1, 1, 1); PG8_STAGE(PG8_SB(1, 0), b3, voffB);
            PG8_BAR; PG8_WAIT_L(0); PG8_MMA(0, 1, At, B1); PG8_BAR;
            PG8_LDA(At, 1, 1); PG8_STAGE(PG8_SA(1, 0), a3, voffA);
            PG8_BAR; PG8_WAIT_L(0); PG8_MMA(1, 0, At, B0); PG8_BAR; PG8_SCHED;
            PG8_STAGE(PG8_SB(1, 1), b3 + hstepB, voffB);
            PG8_WAIT_V(6); PG8_BAR; PG8_MMA(1, 1, At, B1); PG8_BAR;
        }
        E(acc, cur, wr, wc, fr, fq);
        if (!has_next) break;
#pragma unroll
        for (int a = 0; a < 2; ++a)
#pragma unroll
            for (int b = 0; b < 2; ++b)
#pragma unroll
                for (int m = 0; m < 4; ++m)
#pragma unroll
                    for (int n = 0; n < 2; ++n) acc[a][b][m][n] = (f32x4){0.f, 0.f, 0.f, 0.f};
        cur = nxt; cA = nA; cB = nB; ++ui;
    }
    PG8_WAIT_V(0);
    if (wr == 0) PG8_BAR;
    PG8_BAR;
#undef PG8_SA
#undef PG8_SB
#undef PG8_STAGE
#undef PG8_LDA
#undef PG8_LDB
#undef PG8_MMA
#undef PG8_WAIT_V
#undef PG8_WAIT_L
#undef PG8_BAR
#undef PG8_SCHED
}

struct EpiProj {
    static constexpr int PERM = 2;
    bf16_t* O; const float* cosT; const float* sinT;
    __device__ __forceinline__ void operator()(const f32x4 (&acc)[2][2][4][2], const Unit& u, int wr, int wc, int fr, int fq) const {
        const int row0 = u.pm * BM + wr * 64 + fr, j0 = wc * 16 + 4 * fq, colb = u.pn * BM + j0;
        if (u.pn < 8) {
            const float sc = (u.pn < 4) ? QSCALE : 1.0f;
#pragma unroll
            for (int ai = 0; ai < 2; ++ai) {
                f32x4 csv[4], snv[4];
#pragma unroll
                for (int m = 0; m < 4; ++m) { const int pos = (row0 + ai * HALF + m * 16) & (SEQ - 1); csv[m] = *(const f32x4*)(cosT + pos * 64 + j0); snv[m] = *(const f32x4*)(sinT + pos * 64 + j0); }
#pragma unroll
                for (int m = 0; m < 4; ++m) {
                    const int row = row0 + ai * HALF + m * 16;
                    const f32x4 cs = csv[m], sn = snv[m];
                    bf16_t* rowp = O + (size_t)row * DIN + colb;
#pragma unroll
                    for (int bj = 0; bj < 2; ++bj) {
                        const f32x4 a = acc[ai][bj][m][0], b = acc[ai][bj][m][1];
                        const f32x4 o1 = (a * cs - b * sn) * sc, o2 = (b * cs + a * sn) * sc;
                        u32x2 w1, w2; w1.x = cvt_pk_bf16(o1[0], o1[1]); w1.y = cvt_pk_bf16(o1[2], o1[3]); w2.x = cvt_pk_bf16(o2[0], o2[1]); w2.y = cvt_pk_bf16(o2[2], o2[3]);
                        *(u32x2*)(rowp + bj * HALF) = w1; *(u32x2*)(rowp + bj * HALF + 64) = w2;
                    }
                }
            }
        } else {
#pragma unroll
            for (int ai = 0; ai < 2; ++ai)
#pragma unroll
                for (int m = 0; m < 4; ++m) {
                    const int row = row0 + ai * HALF + m * 16;
                    bf16_t* rowp = O + (size_t)row * DIN + colb;
#pragma unroll
                    for (int bj = 0; bj < 2; ++bj) {
                        const f32x4 o1 = acc[ai][bj][m][0], o2 = acc[ai][bj][m][1];
                        u32x2 w1, w2; w1.x = cvt_pk_bf16(o1[0], o1[1]); w1.y = cvt_pk_bf16(o1[2], o1[3]); w2.x = cvt_pk_bf16(o2[0], o2[1]); w2.y = cvt_pk_bf16(o2[2], o2[3]);
                        *(u32x2*)(rowp + bj * HALF) = w1; *(u32x2*)(rowp + bj * HALF + 64) = w2;
                    }
                }
        }
    }
};
struct EpiRes {
    static constexpr int PERM = 1;
    bf16_t* z; const float* gate;
    const float* stats; const float* lng; const float* lnb;
    __device__ __forceinline__ void operator()(const f32x4 (&acc)[2][2][4][2], const Unit& u, int wr, int wc, int fr, int fq) const {
        const int row0 = u.pm * BM + wr * 64 + fr, col0 = u.pn * BM + wc * 32 + 8 * fq;
        const float* gb = gate + (size_t)(row0 >> 12) * (6 * DM);
        const bool ln = stats != nullptr;
        constexpr int GB[4] = {0, 4, 8, 16};
        f32x2 st[4];
#pragma unroll
        for (int grp = 0; grp < 3; ++grp) {
            u32x4 xv[8]; f32x4 cg[2][2], cl[2][2], cb[2][2];
            if (grp == 0 || grp == 2) {
#pragma unroll
                for (int m = 0; m < 4; ++m) st[m] = ln ? *(const f32x2*)(stats + 2 * (row0 + (grp ? HALF : 0) + m * 16)) : (f32x2){0.f, 1.f};
            }
#pragma unroll
            for (int j = GB[grp]; j < GB[grp + 1]; ++j) {
                const int k = j >> 2, m = j & 3, ai = k >> 1, col = col0 + (k & 1) * HALF, kk = k - (GB[grp] >> 2);
                if (m == 0) {
#pragma unroll
                    for (int n = 0; n < 2; ++n) { cg[kk][n] = *(const f32x4*)(gb + col + 4 * n) + 1.0f; cl[kk][n] = (f32x4){1.f, 1.f, 1.f, 1.f}; cb[kk][n] = (f32x4){0.f, 0.f, 0.f, 0.f};
                        if (ln) { cl[kk][n] = *(const f32x4*)(lng + col + 4 * n); cb[kk][n] = *(const f32x4*)(lnb + col + 4 * n); } }
                }
                xv[j - GB[grp]] = *(const u32x4*)(z + (size_t)(row0 + ai * HALF + m * 16) * DM + col);
            }
#pragma unroll
            for (int j = GB[grp]; j < GB[grp + 1]; ++j) {
                const int k = j >> 2, m = j & 3, ai = k >> 1, bj = k & 1, col = col0 + bj * HALF, kk = k - (GB[grp] >> 2);
                const u32x4 r = xv[j - GB[grp]];
                f32x4 x0 = {bflo(r.x), bfhi(r.x), bflo(r.y), bfhi(r.y)}, x1 = {bflo(r.z), bfhi(r.z), bflo(r.w), bfhi(r.w)};
                x0 = (x0 - st[m].x) * st[m].y * cl[kk][0] + cb[kk][0]; x1 = (x1 - st[m].x) * st[m].y * cl[kk][1] + cb[kk][1];
                const f32x4 o0 = x0 * ALPHA + cg[kk][0] * acc[ai][bj][m][0], o1 = x1 * ALPHA + cg[kk][1] * acc[ai][bj][m][1];
                u32x4 w; w.x = cvt_pk_bf16(o0[0], o0[1]); w.y = cvt_pk_bf16(o0[2], o0[3]); w.z = cvt_pk_bf16(o1[0], o1[1]); w.w = cvt_pk_bf16(o1[2], o1[3]);
                *(u32x4*)(z + (size_t)(row0 + ai * HALF + m * 16) * DM + col) = w;
            }
        }
    }
};
struct EpiFF1 {
    static constexpr int PERM = 1;
    bf16_t* O;
    __device__ __forceinline__ void operator()(const f32x4 (&acc)[2][2][4][2], const Unit& u, int wr, int wc, int fr, int fq) const {
        const int row0 = u.pm * BM + wr * 64 + fr, col0 = u.pn * BM + wc * 32 + 8 * fq;
#pragma unroll
        for (int ai = 0; ai < 2; ++ai)
#pragma unroll
            for (int m = 0; m < 4; ++m) {
                const int rowi = row0 + ai * HALF + m * 16;
#pragma unroll
                for (int bj = 0; bj < 2; ++bj) {
                    f32x4 v0 = acc[ai][bj][m][0], v1 = acc[ai][bj][m][1];
#pragma unroll
                    for (int j = 0; j < 4; ++j) { const float a = fmaxf(v0[j], 0.f), b = fmaxf(v1[j], 0.f); v0[j] = a * a; v1[j] = b * b; }
                    u32x4 w; w.x = cvt_pk_bf16(v0[0], v0[1]); w.y = cvt_pk_bf16(v0[2], v0[3]); w.z = cvt_pk_bf16(v1[0], v1[1]); w.w = cvt_pk_bf16(v1[2], v1[3]);
                    *(u32x4*)(O + tiled_off(rowi, col0 + bj * HALF, DFF / 64)) = w;
                }
            }
    }
};
}

__device__ __forceinline__ void pro_a_phase(const Params& p, LAS unsigned char* lds) {
    const int tid = opaque_tid();
    LAS float* cond = (LAS float*)lds;
    LAS float* red = (LAS float*)(lds + 32768);
    LAS float* tile = (LAS float*)(lds + 65536);
    float* mod = (float*)(p.ws + WS_MOD);
    const int G = gridDim.x;
    constexpr int N_GEMV = 256, N_ROPE = 512, N_TR = 12288, FIRST_TR = N_GEMV + N_ROPE;
    if ((int)blockIdx.x < N_GEMV) {
        for (int i = tid; i < 4 * DM; i += 512) { const float v = p.c[i]; cond[i] = v / (1.0f + __expf(-v)); }
        __syncthreads();
    }
    int item = blockIdx.x;
    for (; item < FIRST_TR; item += G) {
        if (item < N_GEMV) {
            const int l = item >> 7, n0 = (item & 127) * 96, cq = tid & 31, kg = tid >> 5;
            const float* wp = p.w_mod + (size_t)l * DM * (6 * DM) + (size_t)(kg * 128) * (6 * DM) + n0 + cq * 4;
            const LAS float* cp = cond + kg * 128;
            f32x4 a0 = {0.f, 0.f, 0.f, 0.f}, a1 = a0, a2 = a0, a3 = a0;
            if (cq < 24)
#pragma unroll 8
            for (int k = 0; k < 128; ++k) {
                const f32x4 w = *(const f32x4*)(wp + (size_t)k * (6 * DM));
                a0 += w * cp[k]; a1 += w * cp[DM + k]; a2 += w * cp[2 * DM + k]; a3 += w * cp[3 * DM + k];
            }
            *(LAS f32x4*)(red + (kg * 4 + 0) * 128 + cq * 4) = a0; *(LAS f32x4*)(red + (kg * 4 + 1) * 128 + cq * 4) = a1;
            *(LAS f32x4*)(red + (kg * 4 + 2) * 128 + cq * 4) = a2; *(LAS f32x4*)(red + (kg * 4 + 3) * 128 + cq * 4) = a3;
            __syncthreads();
            { const int b = tid >> 7, col = tid & 127;
              if (col < 96) { float s = p.b_mod[l * 6 * DM + n0 + col];
#pragma unroll
                for (int k2 = 0; k2 < 16; ++k2) s += red[(k2 * 4 + b) * 128 + col];
                mod[((size_t)l * 4 + b) * (6 * DM) + n0 + col] = s; } }
            __syncthreads();
        } else {
            const int idx = (item - N_GEMV) * 512 + tid, pos = idx >> 6, j = idx & 63;
            double invd = 1.0;
#pragma nounroll
            for (int k = 0; k < j; ++k) invd *= 0.86596432336006535;
            const float inv = (float)invd;
            const float ang = (float)pos * inv;
            const double xd = (double)ang, kk = rint(xd * 0.15915494309189535), y = xd - kk * 6.283185307179586, y2 = y * y;
            double s = 1.0, c = 1.0;
#pragma nounroll
            for (int k = 13; k >= 1; --k) { s = 1.0 - s * y2 / (double)((2 * k) * (2 * k + 1)); c = 1.0 - c * y2 / (double)((2 * k - 1) * (2 * k)); }
            ((float*)(p.ws + WS_COS))[idx] = (float)c; ((float*)(p.ws + WS_SIN))[idx] = (float)(y * s);
        }
    }
    auto decode = [&](int tt, const float*& src, bf16_t*& dst, int& K, int& N, int& mode, int& n0, int& k0) {
        const int l = tt / 6144, u = tt % 6144; int v;
        if (u < 1536) { mode = 2; K = DM; N = DIN; v = u; src = p.w_in + (size_t)l * DM * DIN; dst = (bf16_t*)(p.ws + WS_WT_IN) + (size_t)l * DIN * LDU; }
        else if (u < 2048) { mode = 1; K = DM; N = DM; v = u - 1536; src = p.w_out + (size_t)l * DM * DM; dst = (bf16_t*)(p.ws + WS_WT_OUT) + (size_t)l * DM * LDU; }
        else if (u < 4096) { mode = 1; K = DM; N = DFF; v = u - 2048; src = p.w_ff1 + (size_t)l * DM * DFF; dst = (bf16_t*)(p.ws + WS_WT_FF1) + (size_t)l * DFF * LDU; }
        else { mode = 1; K = DFF; N = DM; v = u - 4096; src = p.w_ff2 + (size_t)l * DFF * DM; dst = (bf16_t*)(p.ws + WS_WT_FF2) + (size_t)l * DM * LDH; }
        const int ntn = N >> 6, kt = v / ntn, nt = v % ntn;
        src += (size_t)(kt * 128) * N + nt * 64; n0 = nt * 64; k0 = kt * 128;
    };
    const int lk = tid >> 4, ln4 = tid & 15;
    const int sn = tid >> 4, skc = tid & 15;
    int tt = item - FIRST_TR;
    if (tt < N_TR) {
        const float* src; bf16_t* dst; int K, N, mode, n0, k0; decode(tt, src, dst, K, N, mode, n0, k0);
        f32x4 rg[4];
#pragma unroll
        for (int i = 0; i < 4; ++i) rg[i] = *(const f32x4*)(src + (size_t)(lk + 32 * i) * N + ln4 * 4);
        for (;;) {
#pragma unroll
            for (int i = 0; i < 4; ++i) { LAS float* tp = tile + (lk + 32 * i) * 65 + ln4 * 4; tp[0] = rg[i][0]; tp[1] = rg[i][1]; tp[2] = rg[i][2]; tp[3] = rg[i][3]; }
            asm volatile("s_waitcnt lgkmcnt(0)" ::: "memory"); __builtin_amdgcn_s_barrier(); asm volatile("" ::: "memory");
            bf16_t* cdst = dst; const int cnkt = K >> 6, cmode = mode, cn0 = n0, ck0 = k0;
            const int tn = tt + G;
            if (tn < N_TR) { decode(tn, src, dst, K, N, mode, n0, k0);
#pragma unroll
                for (int i = 0; i < 4; ++i) rg[i] = *(const f32x4*)(src + (size_t)(lk + 32 * i) * N + ln4 * 4); }
#pragma unroll
            for (int i = 0; i < 2; ++i) {
                const int n = sn + 32 * i; const LAS float* tp = tile + (skc * 8) * 65 + n;
                u32x4 w; w.x = cvt_pk_bf16(tp[0], tp[65]); w.y = cvt_pk_bf16(tp[130], tp[195]); w.z = cvt_pk_bf16(tp[260], tp[325]); w.w = cvt_pk_bf16(tp[390], tp[455]);
                const int ng = cn0 + n, np = (ng & ~127) + pg8::bperm_inv(cmode, ng & 127);
                *(u32x4*)(cdst + pg8::tiled_off(np, ck0 + skc * 8, cnkt)) = w;
            }
            asm volatile("s_waitcnt lgkmcnt(0)" ::: "memory"); __builtin_amdgcn_s_barrier(); asm volatile("" ::: "memory");
            if (tn >= N_TR) break;
            tt = tn;
        }
    }
}

template <bool DO_LN>
__device__ __forceinline__ void row_phase(const float* xin, bf16_t* zb, float* xout, const float* g, const float* bta, const float* modl, int sc_off, int sh_off, bf16_t* U, float* stats, int rbase) {
    const int tid = opaque_tid(), wid = tid >> 6, lane = tid & 63;
    const int rstep = rbase >= 0 ? 8 : (int)gridDim.x * 8, rend = rbase >= 0 ? rbase + 64 : T_TOK;
    f32x4 vn[8]; u32x2 vb[8];
    int row = (rbase >= 0 ? rbase : (int)blockIdx.x * 8) + wid;
    if (row < rend) {
#pragma unroll
        for (int i = 0; i < 8; ++i) { if (DO_LN) vb[i] = *(const u32x2*)(zb + (size_t)row * DM + lane * 4 + i * 256); else vn[i] = *(const f32x4*)(xin + (size_t)row * DM + lane * 4 + i * 256); }
    }
    for (; row < rend; row += rstep) {
        f32x4 v[8], scv[8], shv[8];
#pragma unroll
        for (int i = 0; i < 8; ++i) { if (DO_LN) v[i] = (f32x4){bflo(vb[i].x), bfhi(vb[i].x), bflo(vb[i].y), bfhi(vb[i].y)}; else v[i] = vn[i]; }
        { const int nrow = row + rstep;
          if (nrow < rend) {
#pragma unroll
              for (int i = 0; i < 8; ++i) { if (DO_LN) vb[i] = *(const u32x2*)(zb + (size_t)nrow * DM + lane * 4 + i * 256); else vn[i] = *(const f32x4*)(xin + (size_t)nrow * DM + lane * 4 + i * 256); }
          } }
        if (DO_LN) {
            float s = 0.f;
#pragma unroll
            for (int i = 0; i < 8; ++i) s += (v[i][0] + v[i][1]) + (v[i][2] + v[i][3]);
#pragma unroll
            for (int o = 32; o >= 1; o >>= 1) s += __shfl_xor(s, o);
            const float mu = s * (1.0f / DM);
            float q = 0.f;
#pragma unroll
            for (int i = 0; i < 8; ++i) { v[i] -= mu; q += (v[i][0] * v[i][0] + v[i][1] * v[i][1]) + (v[i][2] * v[i][2] + v[i][3] * v[i][3]); }
#pragma unroll
            for (int o = 32; o >= 1; o >>= 1) q += __shfl_xor(q, o);
            const float rstd = rsqrtf(q * (1.0f / DM) + 1e-5f);
            const unsigned voff = (unsigned)lane * 16u;
            {
                f32x4 gg[8], bb[8];
#pragma unroll
                for (int i = 0; i < 8; ++i) { gg[i] = *(const f32x4*)((const char*)g + (voff + (unsigned)i * 1024u)); bb[i] = *(const f32x4*)((const char*)bta + (voff + (unsigned)i * 1024u)); }
#pragma unroll
                for (int i = 0; i < 8; ++i) v[i] = v[i] * rstd * gg[i] + bb[i];
            }
            if (U) {
                const char* mb = (const char*)(modl + (size_t)(row >> 12) * (6 * DM));
#pragma unroll
                for (int i = 0; i < 8; ++i) { scv[i] = *(const f32x4*)(mb + ((unsigned)sc_off * 4u + voff + (unsigned)i * 1024u)); shv[i] = *(const f32x4*)(mb + ((unsigned)sh_off * 4u + voff + (unsigned)i * 1024u)); }
            }
            if (stats) { if (lane == 0) *(f32x2*)(stats + 2 * row) = (f32x2){mu, rstd}; }
            else {
                float* op = xout + (size_t)row * DM + lane * 4;
#pragma unroll
                for (int i = 0; i < 8; ++i) *(f32x4*)(op + i * 256) = v[i];
            }
        }
        if (U) {
            if (!DO_LN) {
                const unsigned voff = (unsigned)lane * 16u;
                const char* mb = (const char*)(modl + (size_t)(row >> 12) * (6 * DM));
#pragma unroll
                for (int i = 0; i < 8; ++i) { scv[i] = *(const f32x4*)(mb + ((unsigned)sc_off * 4u + voff + (unsigned)i * 1024u)); shv[i] = *(const f32x4*)(mb + ((unsigned)sh_off * 4u + voff + (unsigned)i * 1024u)); }
            }
#pragma unroll
            for (int i = 0; i < 8; ++i) {
                const f32x4 uu = v[i] * (scv[i] + 1.0f) + shv[i];
                u32x2 w; w.x = cvt_pk_bf16(uu[0], uu[1]); w.y = cvt_pk_bf16(uu[2], uu[3]);
                *(u32x2*)(U + pg8::tiled_off(row, i * 256 + lane * 4, DM / 64)) = w;
                if (!DO_LN) { u32x2 wz; wz.x = cvt_pk_bf16(v[i][0], v[i][1]); wz.y = cvt_pk_bf16(v[i][2], v[i][3]); *(u32x2*)(zb + (size_t)row * DM + lane * 4 + i * 256) = wz; }
            }
        }
    }
}

struct AttnStep { size_t tb; int h, dl, r, n, br, first; };
__device__ __forceinline__ AttnStep attn_step(int wg, int q, int mode) {
    AttnStep a;
    if (mode) { const int bh = wg >> 3; a.tb = (size_t)(bh >> 3) * SEQ; a.h = bh & 7; a.br = 0; a.dl = 0; a.r = 0; a.n = 4 * (wg & 7) + q; a.first = (q == 0); }
    else if (wg < 128) { a.tb = (size_t)(wg >> 5) * SEQ; a.h = (wg >> 2) & 7; a.br = 1; a.dl = 2; a.r = wg & 3; a.n = q; a.first = (q == 0); }
    else { const int c16 = (wg - 128) * 4 + (q >> 1); a.tb = (size_t)(c16 >> 7) * SEQ; a.h = (c16 >> 4) & 7; a.br = 2; a.dl = 4; a.r = c16 & 15; a.n = q & 1; a.first = !(q & 1); }
    return a;
}
__device__ __forceinline__ void attn_phase(const Params& p, LAS unsigned char* lds, int l, int mode) {
    const bf16_t* proj = (const bf16_t*)(p.ws + WS_PROJ);
    bf16_t* opart = (bf16_t*)(p.ws + WS_OPART); float* lse = (float*)(p.ws + WS_LSE);
    bf16_t* mixed = (bf16_t*)(p.ws + WS_U);
    const float* gain = p.mix_g + (size_t)l * DM;
    const int tid = opaque_tid(), wid = tid >> 6, lane = tid & 63, li = lane & 15, g = lane >> 4;
    LAS unsigned char* Kl = lds; LAS unsigned char* Vl = lds + 256 * 272;
    constexpr int KH = 128 * 272, VH = 128 * 288;
    const int nsteps = mode ? 4 : 8;
    u32x4 kv[4], vv[4]; bf16x8 qf[4];
#define ATTN_LOAD_BLK(A, NB) do { _Pragma("unroll") for (int i = 0; i < 4; ++i) { const int idx = tid + 512 * i, row = idx >> 4, ch = idx & 15; \
            const bf16_t* src = proj + ((A).tb + ((size_t)((NB) * 128 + row) << (A).dl) + (A).r) * DIN + (A).h * 128 + ch * 8; kv[i] = *(const u32x4*)(src + 1024); vv[i] = *(const u32x4*)(src + 2048); } } while (0)
#define ATTN_STORE_BLK(HH) do { _Pragma("unroll") for (int i = 0; i < 4; ++i) { const int idx = tid + 512 * i, row = idx >> 4, ch = idx & 15; \
            *(LAS u32x4*)(Kl + (HH) * KH + row * 272 + ch * 16) = kv[i]; *(LAS u32x4*)(Vl + (HH) * VH + row * 288 + ch * 16) = vv[i]; } } while (0)
#define ATTN_LOAD_Q(A) do { const size_t qt_ = (A).tb + ((size_t)((A).n * 128 + wid * 16 + li) << (A).dl) + (A).r; \
            _Pragma("unroll") for (int s = 0; s < 4; ++s) qf[s] = *(const bf16x8*)(proj + qt_ * DIN + (A).h * 128 + s * 32 + g * 8); } while (0)
    for (int wg = blockIdx.x; wg < 256; wg += gridDim.x) {
        AttnStep cur = attn_step(wg, 0, mode);
        if (mode && cur.n > 0) { ATTN_LOAD_BLK(cur, cur.n - 1); ATTN_STORE_BLK(1); }
        ATTN_LOAD_BLK(cur, cur.n); ATTN_LOAD_Q(cur);
        for (int q = 0; q < nsteps; ++q) {
            const int c = q & 1;
            if (cur.first && cur.n == 0) {
#pragma unroll
                for (int i = 0; i < 4; ++i) { const int idx = tid + 512 * i, row = idx >> 4, ch = idx & 15;
                    *(LAS u32x4*)(Kl + (c ^ 1) * KH + row * 272 + ch * 16) = (u32x4){0u, 0u, 0u, 0u}; *(LAS u32x4*)(Vl + (c ^ 1) * VH + row * 288 + ch * 16) = (u32x4){0u, 0u, 0u, 0u}; }
            }
            ATTN_STORE_BLK(c);
            bf16x8 qc[4];
#pragma unroll
            for (int s = 0; s < 4; ++s) qc[s] = qf[s];
            asm volatile("s_waitcnt lgkmcnt(0)" ::: "memory"); __builtin_amdgcn_s_barrier(); asm volatile("" ::: "memory");
            AttnStep nxt = attn_step(wg, (q + 1 < nsteps) ? q + 1 : q, mode);
            if (q + 1 < nsteps) { ATTN_LOAD_BLK(nxt, nxt.n); ATTN_LOAD_Q(nxt); }
            const int n = cur.n, dl = cur.dl, h = cur.h, mbase = (n - 1) * 128;
            const int qi = wid * 16 + li; const size_t qtok = cur.tb + ((size_t)(n * 128 + qi) << dl) + cur.r;
            const int kb0 = wid & ~1;
            const int koffP = (c ^ 1) * KH, koffC = c * KH, voffP = (c ^ 1) * VH, voffC = c * VH;
            f32x4 sacc[10];
#pragma unroll
            for (int i = 0; i < 10; ++i) {
                sacc[i] = (f32x4){0.f, 0.f, 0.f, 0.f};
                const int kb = kb0 + i, koff = (kb < 8) ? koffP + kb * (16 * 272) : koffC + (kb - 8) * (16 * 272);
#pragma unroll
                for (int s = 0; s < 4; ++s) {
                    const bf16x8 kf = *(const LAS bf16x8*)(Kl + koff + li * 272 + (32 * s + 8 * g) * 2);
                    sacc[i] = __builtin_amdgcn_mfma_f32_16x16x32_bf16(kf, qc[s], sacc[i], 0, 0, 0);
                }
            }
            float mx = -1e30f;
#pragma unroll
            for (int i = 0; i < 10; ++i)
#pragma unroll
                for (int j = 0; j < 4; ++j) {
                    const int kj = 16 * (kb0 + i) + 4 * g + j, dist = 128 + qi - kj;
                    const bool valid = (dist >= 0) && (dist <= 128) && (mbase + kj >= 0);
                    const float sv = valid ? sacc[i][j] : -1e30f;
                    sacc[i][j] = sv; mx = fmaxf(mx, sv);
                }
            mx = fmaxf(mx, __shfl_xor(mx, 16)); mx = fmaxf(mx, __shfl_xor(mx, 32));
            float lsum = 0.f;
#pragma unroll
            for (int i = 0; i < 10; ++i)
#pragma unroll
                for (int j = 0; j < 4; ++j) { const float pv = __builtin_amdgcn_exp2f(sacc[i][j] - mx); sacc[i][j] = pv; lsum += pv; }
            lsum += __shfl_xor(lsum, 16); lsum += __shfl_xor(lsum, 32);
            u32x2 x1[8], x2[8]; float l1 = 0.f, l2 = 0.f;
            if (mode) {
                l1 = lse[qtok * 8 + h]; l2 = lse[((size_t)T_TOK + qtok) * 8 + h];
                const bf16_t* p1 = opart + qtok * 1024 + h * 128 + 4 * g; const bf16_t* p2 = p1 + (size_t)T_TOK * 1024;
#pragma unroll
                for (int db = 0; db < 8; ++db) { x1[db] = *(const u32x2*)(p1 + 16 * db); x2[db] = *(const u32x2*)(p2 + 16 * db); }
            }
            f32x4 oacc[8];
#pragma unroll
            for (int db = 0; db < 8; ++db) oacc[db] = (f32x4){0.f, 0.f, 0.f, 0.f};
            const int vlane = (4 * g + (li >> 2)) * 288 + (4 * (li & 3)) * 2;
#pragma unroll
            for (int t = 0; t < 5; ++t) {
                u32x4 pw; pw.x = cvt_pk_bf16(sacc[2 * t][0], sacc[2 * t][1]); pw.y = cvt_pk_bf16(sacc[2 * t][2], sacc[2 * t][3]);
                pw.z = cvt_pk_bf16(sacc[2 * t + 1][0], sacc[2 * t + 1][1]); pw.w = cvt_pk_bf16(sacc[2 * t + 1][2], sacc[2 * t + 1][3]);
                const bf16x8 pf = __builtin_bit_cast(bf16x8, pw);
                const int kbv = kb0 + 2 * t, voff = (kbv < 8) ? voffP + kbv * (16 * 288) : voffC + (kbv - 8) * (16 * 288);
                const LAS unsigned char* vb = Vl + voff + vlane;
#pragma unroll
                for (int db = 0; db < 8; ++db) {
                    const s16x4 lo = __builtin_bit_cast(s16x4, __builtin_amdgcn_ds_read_tr16_b64_v4i16((LAS s16x4*)(vb + db * 32)));
                    const s16x4 hi = __builtin_bit_cast(s16x4, __builtin_amdgcn_ds_read_tr16_b64_v4i16((LAS s16x4*)(vb + 16 * 288 + db * 32)));
                    const bf16x8 vf = __builtin_shufflevector(lo, hi, 0, 1, 2, 3, 4, 5, 6, 7);
                    oacc[db] = __builtin_amdgcn_mfma_f32_16x16x32_bf16(vf, pf, oacc[db], 0, 0, 0);
                }
            }
            const float inv = 1.0f / lsum, lse0 = mx + __builtin_amdgcn_logf(lsum);
            if (mode == 0) {
                bf16_t* op = opart + ((size_t)(cur.br - 1) * T_TOK + qtok) * 1024 + h * 128 + 4 * g;
#pragma unroll
                for (int db = 0; db < 8; ++db) { const f32x4 o = oacc[db] * inv; u32x2 w; w.x = cvt_pk_bf16(o[0], o[1]); w.y = cvt_pk_bf16(o[2], o[3]); *(u32x2*)(op + 16 * db) = w; }
                if (g == 0) lse[((size_t)(cur.br - 1) * T_TOK + qtok) * 8 + h] = lse0;
            } else {
                const float lm = fmaxf(lse0, fmaxf(l1, l2));
                const float w0 = __builtin_amdgcn_exp2f(lse0 - lm), w1 = __builtin_amdgcn_exp2f(l1 - lm), w2 = __builtin_amdgcn_exp2f(l2 - lm);
                const float wi = 1.0f / (w0 + w1 + w2), a0 = w0 * wi * inv, a1 = w1 * wi, a2 = w2 * wi;
                float ss = 0.f;
#pragma unroll
                for (int db = 0; db < 8; ++db) {
                    f32x4 o = oacc[db] * a0;
                    o[0] += bflo(x1[db].x) * a1 + bflo(x2[db].x) * a2; o[1] += bfhi(x1[db].x) * a1 + bfhi(x2[db].x) * a2;
                    o[2] += bflo(x1[db].y) * a1 + bflo(x2[db].y) * a2; o[3] += bfhi(x1[db].y) * a1 + bfhi(x2[db].y) * a2;
                    oacc[db] = o; ss += (o[0] * o[0] + o[1] * o[1]) + (o[2] * o[2] + o[3] * o[3]);
                }
                ss += __shfl_xor(ss, 16); ss += __shfl_xor(ss, 32);
                const float rs = rsqrtf(ss * (1.0f / 128.0f) + 1e-6f);
                f32x4 ggv[8];
#pragma unroll
                for (int db = 0; db < 8; ++db) ggv[db] = *(const f32x4*)(gain + h * 128 + 16 * db + 4 * g);
#pragma unroll
                for (int db = 0; db < 8; ++db) {
                    const f32x4 gg = ggv[db];
                    const f32x4 o = oacc[db] * rs * gg;
                    u32x2 w; w.x = cvt_pk_bf16(o[0], o[1]); w.y = cvt_pk_bf16(o[2], o[3]);
                    *(u32x2*)(mixed + pg8::tiled_off((int)qtok, h * 128 + 16 * db + 4 * g, DM / 64)) = w;
                }
            }
            asm volatile("s_waitcnt lgkmcnt(0)" ::: "memory"); __builtin_amdgcn_s_barrier(); asm volatile("" ::: "memory");
            cur = nxt;
        }
    }
#undef ATTN_LOAD_BLK
#undef ATTN_STORE_BLK
#undef ATTN_LOAD_Q
}

__device__ __forceinline__ void conv_phase(const Params& p, int l) {
    const bf16_t* proj = (const bf16_t*)(p.ws + WS_PROJ);
    bf16_t* mixed = (bf16_t*)(p.ws + WS_U);
    const float* gain = p.mix_g + (size_t)l * DM; const float* cw = p.conv_w + (size_t)l * 3 * 1024;
    const int tid = opaque_tid(), wid = tid >> 6, lane = tid & 63;
    u32x2 ngb[4], ngc0[4], nhi0[4], ngc1[4], nhi1[4], ngc2[4], nhi2[4];
#define CONV_LOAD(T) do { const int pos_ = (T) & (SEQ - 1); _Pragma("unroll") for (int i = 0; i < 4; ++i) { \
            const bf16_t* pr = proj + (size_t)(T) * DIN + i * 256 + lane * 4; \
            ngb[i] = *(const u32x2*)(pr + 3072); ngc0[i] = *(const u32x2*)(pr + 4096); nhi0[i] = *(const u32x2*)(pr + 5120); \
            ngc1[i] = (u32x2){0u, 0u}; nhi1[i] = ngc1[i]; ngc2[i] = ngc1[i]; nhi2[i] = ngc1[i]; \
            if (pos_ >= 1) { ngc1[i] = *(const u32x2*)(pr - DIN + 4096); nhi1[i] = *(const u32x2*)(pr - DIN + 5120); } \
            if (pos_ >= 2) { ngc2[i] = *(const u32x2*)(pr - 2 * DIN + 4096); nhi2[i] = *(const u32x2*)(pr - 2 * DIN + 5120); } } } while (0)
    int t = blockIdx.x * 8 + wid;
    if (t < T_TOK) CONV_LOAD(t);
    for (; t < T_TOK; t += gridDim.x * 8) {
        u32x2 gb[4], gc0[4], hi0[4], gc1[4], hi1[4], gc2[4], hi2[4];
#pragma unroll
        for (int i = 0; i < 4; ++i) { gb[i] = ngb[i]; gc0[i] = ngc0[i]; hi0[i] = nhi0[i]; gc1[i] = ngc1[i]; hi1[i] = nhi1[i]; gc2[i] = ngc2[i]; hi2[i] = nhi2[i]; }
        { const int tn = t + gridDim.x * 8; if (tn < T_TOK) CONV_LOAD(tn); }
        f32x4 cw0[4], cw1[4], cw2[4], g2[4];
#pragma unroll
        for (int i = 0; i < 4; ++i) { const int col = i * 256 + lane * 4;
            cw0[i] = *(const f32x4*)(cw + col); cw1[i] = *(const f32x4*)(cw + 1024 + col); cw2[i] = *(const f32x4*)(cw + 2048 + col); g2[i] = *(const f32x4*)(gain + 1024 + col); }
#pragma unroll
        for (int i = 0; i < 4; ++i) {
            const int col = i * 256 + lane * 4;
            f32x4 c0, c1, c2, gbv;
            c0[0] = bflo(gc0[i].x) * bflo(hi0[i].x); c0[1] = bfhi(gc0[i].x) * bfhi(hi0[i].x); c0[2] = bflo(gc0[i].y) * bflo(hi0[i].y); c0[3] = bfhi(gc0[i].y) * bfhi(hi0[i].y);
            c1[0] = bflo(gc1[i].x) * bflo(hi1[i].x); c1[1] = bfhi(gc1[i].x) * bfhi(hi1[i].x); c1[2] = bflo(gc1[i].y) * bflo(hi1[i].y); c1[3] = bfhi(gc1[i].y) * bfhi(hi1[i].y);
            c2[0] = bflo(gc2[i].x) * bflo(hi2[i].x); c2[1] = bfhi(gc2[i].x) * bfhi(hi2[i].x); c2[2] = bflo(gc2[i].y) * bflo(hi2[i].y); c2[3] = bfhi(gc2[i].y) * bfhi(hi2[i].y);
            gbv[0] = bflo(gb[i].x); gbv[1] = bfhi(gb[i].x); gbv[2] = bflo(gb[i].y); gbv[3] = bfhi(gb[i].y);
            f32x4 y = gbv * (cw0[i] * c2 + cw1[i] * c1 + cw2[i] * c0);
            float s2 = (y[0] * y[0] + y[1] * y[1]) + (y[2] * y[2] + y[3] * y[3]);
#pragma unroll
            for (int sft = 16; sft >= 1; sft >>= 1) s2 += __shfl_xor(s2, sft);
            const float rs2 = rsqrtf(s2 * (1.0f / 128.0f) + 1e-6f);
            y = y * rs2 * g2[i];
            u32x2 wy; wy.x = cvt_pk_bf16(y[0], y[1]); wy.y = cvt_pk_bf16(y[2], y[3]);
            *(u32x2*)(mixed + pg8::tiled_off(t, 1024 + col, DM / 64)) = wy;
        }
    }
#undef CONV_LOAD
}

#define XB_TMO      128
#define XB_XCNT(j)  (256  + 64 * (j))
#define XB_XSUB(j)  (1280 + 64 * (j))
#define XB_XGEN(j)  (2304 + 64 * (j))
#define XB_TOP      3328
#define XB_TOPGEN   3392
#define XB_LSUB(j)  (3456 + 64 * (j))
#define XB_LGEN(j)  (3968 + 64 * (j))
#define XCD_BAR_WORDS 4480
#define XB_SPIN_CAP (1u << 22)
__device__ __forceinline__ unsigned xb_ld(unsigned* p)              { return __hip_atomic_load(p, __ATOMIC_RELAXED, __HIP_MEMORY_SCOPE_AGENT); }
__device__ __forceinline__ unsigned xb_add(unsigned* p, unsigned v) { return __hip_atomic_fetch_add(p, v, __ATOMIC_RELAXED, __HIP_MEMORY_SCOPE_AGENT); }
#define XB_SPIN(cond, bar) do { unsigned _sp = 0; while (cond) { __builtin_amdgcn_s_sleep(1); \
    if ((++_sp & 255u) == 0u) { if (xb_ld(&(bar)[XB_TMO])) break; if (_sp > XB_SPIN_CAP) { atomicAdd(&(bar)[XB_TMO], 1u); break; } } } } while (0)
struct XcdBarrier { unsigned* bar; unsigned x; volatile LAS unsigned* st; };
__device__ __forceinline__ void xcd_barrier_complete(unsigned* bar, unsigned x, unsigned& nloc, unsigned& nx) {
    const unsigned G = gridDim.x * gridDim.y * gridDim.z;
    unsigned sum, cnt, mine, sp = 0u;
    for (;;) {
        sum = 0u; cnt = 0u; mine = 0u;
#pragma unroll
        for (unsigned j = 0; j < 16; ++j) { const unsigned c = xb_ld(&bar[XB_XCNT(j)]); sum += c; cnt += (c > 0u) ? 1u : 0u; mine = (j == x) ? c : mine; }
        if (sum == G) break;
        __builtin_amdgcn_s_sleep(1);
        if ((++sp & 255u) == 0u) { if (xb_ld(&bar[XB_TMO])) break; if (sp > XB_SPIN_CAP) { atomicAdd(&bar[XB_TMO], 1u); break; } }
    }
    nloc = mine > 0u ? mine : 1u; nx = cnt > 0u ? cnt : 1u;
}
__device__ __forceinline__ void xcd_barrier(const XcdBarrier& b) {
    asm volatile("s_waitcnt vmcnt(0)" ::: "memory");
    __syncthreads();
    if (threadIdx.x == 0) {
        unsigned* bar = b.bar;
        __builtin_amdgcn_s_waitcnt(0);
        unsigned nloc = b.st[0], nx = b.st[1];
        if (nloc == 0u) { xcd_barrier_complete(bar, b.x, nloc, nx); b.st[0] = nloc; b.st[1] = nx; }
        const unsigned old = xb_add(&bar[XB_XSUB(b.x)], 1u);
        const unsigned gen = old / nloc;
        if (old + 1u == (gen + 1u) * nloc) {
            __builtin_amdgcn_fence(__ATOMIC_RELEASE, "agent");
            asm volatile("s_waitcnt vmcnt(0)" ::: "memory");
            const unsigned og = xb_add(&bar[XB_TOP], 1u);
            const unsigned tg = og / nx;
            if (og + 1u == (tg + 1u) * nx) xb_add(&bar[XB_TOPGEN], 1u);
            else XB_SPIN(xb_ld(&bar[XB_TOPGEN]) == tg, bar);
            __builtin_amdgcn_fence(__ATOMIC_ACQUIRE, "agent");
            xb_add(&bar[XB_XGEN(b.x)], 1u);
            asm volatile("s_waitcnt vmcnt(0)" ::: "memory");
        } else {
            XB_SPIN(xb_ld(&bar[XB_XGEN(b.x)]) == gen, bar);
            __builtin_amdgcn_fence(__ATOMIC_ACQUIRE, "agent");
            asm volatile("s_waitcnt vmcnt(0)" ::: "memory");
        }
    }
    __syncthreads();
}

__device__ __forceinline__ void xcd_local_barrier(const XcdBarrier& b, unsigned nloc) {
    asm volatile("s_waitcnt vmcnt(0)" ::: "memory");
    __syncthreads();
    if (threadIdx.x == 0) {
        unsigned* bar = b.bar;
        __builtin_amdgcn_s_waitcnt(0);
        const unsigned old = xb_add(&bar[XB_LSUB(b.x)], 1u);
        const unsigned gen = old / nloc;
        if (old + 1u == (gen + 1u) * nloc) xb_add(&bar[XB_LGEN(b.x)], 1u);
        else XB_SPIN(xb_ld(&bar[XB_LGEN(b.x)]) == gen, bar);
        __builtin_amdgcn_fence(__ATOMIC_ACQUIRE, "agent");
        asm volatile("s_waitcnt vmcnt(0)" ::: "memory");
    }
    __syncthreads();
}

__global__ void __launch_bounds__(512, 2) fwd_megakernel(Params p) {
    extern __shared__ __attribute__((aligned(16))) unsigned char shm[];
    LAS unsigned char* lds = (LAS unsigned char*)shm;
    const float* mod = (const float*)(p.ws + WS_MOD);
    bf16_t* zb = (bf16_t*)(p.ws + WS_ZB);
    int vc = blockIdx.x, myrank = 0; bool xlocal = false;
    unsigned* bar = (unsigned*)(p.ws + WS_CTL);
    XcdBarrier xb; xb.bar = bar; xb.x = (unsigned)__builtin_amdgcn_s_getreg((3 << 11) | 20) & 0xFu; xb.st = (volatile LAS unsigned*)(lds + LDS_ST);
    const bool fused = (p.ph_hi - p.ph_lo) > 1;
    if (p.never) cg::this_grid().sync();
    if (fused) {
        if (threadIdx.x == 0) { xb.st[0] = 0u; xb.st[1] = 0u; xb.st[2] = xb_add(&bar[XB_XCNT(xb.x)], 1u); }
        __syncthreads();
        myrank = (int)xb.st[2];
    }
    for (int ph = p.ph_lo; ph < p.ph_hi; ++ph) {
        if (ph > p.ph_lo) {
            const int sb = (ph - 2) & 7;
            if (ph >= 2 && xlocal && sb >= 4) xcd_local_barrier(xb, gridDim.x / 8); else xcd_barrier(xb);
        }
        if (ph == 1 && fused) {
            unsigned cc[16];
#pragma unroll
            for (int i = 0; i < 16; ++i) cc[i] = xb_ld(&bar[XB_XCNT(i)]);
            unsigned bad = gridDim.x & 7u;
#pragma unroll
            for (int i = 0; i < 16; ++i) bad |= cc[i] ^ (i < 8 ? gridDim.x / 8 : 0u);
            if (bad == 0u) { vc = myrank * 8 + (int)xb.x; xlocal = gridDim.x == 256; }
        }
        if (ph == 0) { pro_a_phase(p, lds); continue; }
        if (ph == 1) { row_phase<false>(p.x, zb, nullptr, nullptr, nullptr, mod, 1 * DM, 0, (bf16_t*)(p.ws + WS_U), nullptr, -1); continue; }
        const int l = (ph - 2) >> 3, s = (ph - 2) & 7;
        const float* modl = mod + (size_t)l * 4 * 6 * DM;
        float* stats = (float*)(p.ws + WS_STATS);
        const int rown = gridDim.x == 256 ? (vc & 7) * 2048 + (vc >> 3) * 64 : -1;
        pg8::StaticOrder S;
        if (s == 0) {
            pg8::Gemm g{(const bf16_t*)(p.ws + WS_U), (const bf16_t*)(p.ws + WS_WT_IN) + (size_t)l * DIN * LDU, T_TOK, DIN, DM, LDU, LDU};
            S.init(g.M, g.N, gridDim.x, vc);
            pg8::EpiProj E{(bf16_t*)(p.ws + WS_PROJ), (const float*)(p.ws + WS_COS), (const float*)(p.ws + WS_SIN)};
            pg8::gemm_phase<pg8::EpiProj>(lds, g, S, E);
        } else if (s == 1) {
            attn_phase(p, lds, l, 0); conv_phase(p, l);
        } else if (s == 2) {
            attn_phase(p, lds, l, 1);
        } else if (s == 3 || s == 6) {
            pg8::Gemm g; pg8::EpiRes E;
            if (s == 3) { g = pg8::Gemm{(const bf16_t*)(p.ws + WS_U), (const bf16_t*)(p.ws + WS_WT_OUT) + (size_t)l * DM * LDU, T_TOK, DM, DM, LDU, LDU};
                          E = pg8::EpiRes{zb, modl + 2 * DM, l == 0 ? nullptr : stats, p.ln2_g + (size_t)(l - (l > 0)) * DM, p.ln2_b + (size_t)(l - (l > 0)) * DM}; }
            else        { g = pg8::Gemm{(const bf16_t*)(p.ws + WS_H), (const bf16_t*)(p.ws + WS_WT_FF2) + (size_t)l * DM * LDH, T_TOK, DM, DFF, LDH, LDH};
                          E = pg8::EpiRes{zb, modl + 5 * DM, stats, p.ln1_g + (size_t)l * DM, p.ln1_b + (size_t)l * DM}; }
            S.init(g.M, g.N, gridDim.x, vc);
            pg8::gemm_phase<pg8::EpiRes>(lds, g, S, E);
        } else if (s == 4 || s == 7) {
            if (s == 4) row_phase<true>(nullptr, zb, p.out, p.ln1_g + (size_t)l * DM, p.ln1_b + (size_t)l * DM, modl, 4 * DM, 3 * DM, (bf16_t*)(p.ws + WS_U), stats, rown);
            else        row_phase<true>(nullptr, zb, p.out, p.ln2_g + (size_t)l * DM, p.ln2_b + (size_t)l * DM, modl + (size_t)4 * 6 * DM, 1 * DM, 0, (l + 1 < NLAYER) ? (bf16_t*)(p.ws + WS_U) : nullptr, (l + 1 < NLAYER) ? stats : nullptr, rown);
        } else {
            pg8::Gemm g{(const bf16_t*)(p.ws + WS_U), (const bf16_t*)(p.ws + WS_WT_FF1) + (size_t)l * DFF * LDU, T_TOK, DFF, DM, LDU, LDU};
            S.init(g.M, g.N, gridDim.x, vc);
            pg8::EpiFF1 E{(bf16_t*)(p.ws + WS_H)};
            pg8::gemm_phase<pg8::EpiFF1>(lds, g, S, E);
        }
    }
}

constexpr int N_PHASES = 2 + 8 * NLAYER;

extern "C" void kernel_launch(void* const* d_in, const int* in_sizes, int n_in, void* d_out, int out_size, void* d_ws, size_t ws_size, hipStream_t stream) {
    static int grid = 0;
    if (grid == 0) {
        int dev = 0, cus = 0, per_cu = 0;
        (void)hipGetDevice(&dev);
        (void)hipDeviceGetAttribute(&cus, hipDeviceAttributeMultiprocessorCount, dev);
        if (hipFuncSetAttribute((const void*)fwd_megakernel, hipFuncAttributeMaxDynamicSharedMemorySize, LDS_BYTES) != hipSuccess) fprintf(stderr, "hipFuncSetAttribute failed\n");
        if (hipOccupancyMaxActiveBlocksPerMultiprocessor(&per_cu, (const void*)fwd_megakernel, 512, LDS_BYTES) != hipSuccess || per_cu < 1) per_cu = 1;
        (void)hipGetLastError();
        grid = cus * per_cu;
        if (ws_size < WS_END) fprintf(stderr, "workspace too small: %zu < %zu\n", ws_size, (size_t)WS_END);
    }
    Params p{};
    p.x = (const float*)d_in[0]; p.c = (const float*)d_in[1]; p.w_in = (const float*)d_in[2]; p.conv_w = (const float*)d_in[3]; p.mix_g = (const float*)d_in[4];
    p.w_out = (const float*)d_in[5]; p.w_mod = (const float*)d_in[6]; p.b_mod = (const float*)d_in[7]; p.ln1_g = (const float*)d_in[8]; p.ln1_b = (const float*)d_in[9];
    p.w_ff1 = (const float*)d_in[10]; p.w_ff2 = (const float*)d_in[11]; p.ln2_g = (const float*)d_in[12]; p.ln2_b = (const float*)d_in[13];
    p.out = (float*)d_out; p.ws = (unsigned char*)d_ws;
#if SINGLE_LAUNCH
    (void)hipMemsetAsync((unsigned char*)d_ws + WS_CTL, 0, 20480, stream);
    p.ph_lo = 0; p.ph_hi = N_PHASES;
    void* args[] = {&p};
    hipError_t e = hipLaunchCooperativeKernel((const void*)fwd_megakernel, dim3(grid), dim3(512), args, LDS_BYTES, stream);
    if (e != hipSuccess) fprintf(stderr, "cooperative launch failed: %s (grid %d)\n", hipGetErrorString(e), grid);
#else
    for (int ph = 0; ph < N_PHASES; ++ph) {
        p.ph_lo = ph; p.ph_hi = ph + 1;
        hipLaunchKernelGGL(fwd_megakernel, dim3(grid), dim3(512), LDS_BYTES, stream, p);
    }
#endif
}
```

```cpp
#include <hip/hip_runtime.h>
#include <hip/hip_cooperative_groups.h>
#include <cstdio>
namespace cg = cooperative_groups;

#ifndef SINGLE_LAUNCH
#define SINGLE_LAUNCH 1
#endif

#define LAS __attribute__((address_space(3)))
typedef unsigned short bf16_t;
typedef short bf16x8 __attribute__((ext_vector_type(8)));
typedef short s16x4 __attribute__((ext_vector_type(4)));
typedef float f32x4 __attribute__((ext_vector_type(4)));
typedef float f32x2 __attribute__((ext_vector_type(2)));
typedef unsigned u32x4 __attribute__((ext_vector_type(4)));
typedef unsigned u32x2 __attribute__((ext_vector_type(2)));

constexpr int T_TOK = 16384, SEQ = 4096, DM = 2048, DIN = 6144, DFF = 8192, NLAYER = 2;
constexpr int KPAD = 0, LDU = DM + KPAD, LDH = DFF + KPAD;
constexpr float ALPHA = 1.4142135623730951f;
constexpr float QSCALE = 0.08838834764831845f * 1.4426950408889634f;

constexpr size_t WS_WT_IN = 0;
constexpr size_t WS_WT_OUT = WS_WT_IN + (size_t)NLAYER * DIN * LDU * 2;
constexpr size_t WS_WT_FF1 = WS_WT_OUT + (size_t)NLAYER * DM * LDU * 2;
constexpr size_t WS_WT_FF2 = WS_WT_FF1 + (size_t)NLAYER * DFF * LDU * 2;
constexpr size_t WS_MOD = WS_WT_FF2 + (size_t)NLAYER * DM * LDH * 2;
constexpr size_t WS_COS = WS_MOD + (size_t)NLAYER * 4 * 6 * DM * 4;
constexpr size_t WS_SIN = WS_COS + (size_t)SEQ * 64 * 4;
constexpr size_t WS_U = WS_SIN + (size_t)SEQ * 64 * 4;
constexpr size_t WS_PROJ = WS_U + (size_t)T_TOK * LDU * 2;
constexpr size_t WS_OPART = WS_PROJ + (size_t)T_TOK * DIN * 2;
constexpr size_t WS_LSE = WS_OPART + (size_t)3 * T_TOK * 1024 * 4;
constexpr size_t WS_CTL = WS_LSE + (size_t)3 * T_TOK * 8 * 4;
constexpr size_t WS_STATS = WS_CTL + 20480;
constexpr size_t WS_END = WS_STATS + (size_t)T_TOK * 2 * 4;
constexpr size_t WS_ZB = WS_OPART + (size_t)2 * T_TOK * 1024 * 2;
constexpr size_t WS_H = WS_PROJ;

constexpr int LDS_ST = 256 * 272 + 256 * 288;
constexpr int LDS_BYTES = LDS_ST + 16;

struct Params {
    const float* x; const float* c; const float* w_in; const float* conv_w; const float* mix_g; const float* w_out;
    const float* w_mod; const float* b_mod; const float* ln1_g; const float* ln1_b; const float* w_ff1; const float* w_ff2;
    const float* ln2_g; const float* ln2_b;
    float* out; unsigned char* ws;
    int ph_lo, ph_hi, never, pad;
};

__device__ __forceinline__ unsigned cvt_pk_bf16(float lo, float hi) { unsigned r; asm volatile("v_cvt_pk_bf16_f32 %0, %1, %2" : "=v"(r) : "v"(lo), "v"(hi)); return r; }
__device__ __forceinline__ int opaque_tid() { int t = threadIdx.x; asm volatile("" : "+v"(t)); return t; }
__device__ __forceinline__ float bf2f(unsigned short b) { return __uint_as_float(((unsigned)b) << 16); }
__device__ __forceinline__ float bflo(unsigned w) { return __uint_as_float(w << 16); }
__device__ __forceinline__ float bfhi(unsigned w) { return __uint_as_float(w & 0xffff0000u); }

namespace pg8 {
constexpr int BM = 256, BK = 64, HALF = 128, HTB = HALF * BK * 2, STAGE_BYTES = 8 * HTB, NXCD = 8, WGM = 8;
__device__ __forceinline__ int lds_byte(int r, int c) { const int st = (r >> 4) * 2 + (c >> 5), rr = r & 15, cc = c & 31, ob = rr * 64 + cc * 2; return st * 1024 + (ob ^ (((ob >> 9) & 1) << 5)); }
__device__ __forceinline__ void stage_rc(int b, int& R, int& C) { const int st = b / 1024, sb = b % 1024, swz = sb ^ (((sb >> 9) & 1) << 5); R = (st >> 1) * 16 + swz / 64; C = (st & 1) * 32 + (swz % 64) / 2; }
__device__ __forceinline__ int perm32(int rho) { const int n = rho >> 4, i = rho & 15; return 8 * (i >> 2) + 4 * n + (i & 3); }
__device__ __forceinline__ int bperm(int mode, int R) {
    if (mode == 1) return (R & ~31) + perm32(R & 31);
    if (mode == 2) return 64 * ((R >> 4) & 1) + 16 * (R >> 5) + (R & 15);
    return R;
}
__device__ __forceinline__ int bperm_inv(int mode, int s) {
    if (mode == 1) { const int t = s & 31; return (s & ~31) + 16 * ((t >> 2) & 1) + 4 * (t >> 3) + (t & 3); }
    if (mode == 2) return 32 * ((s >> 4) & 3) + 16 * (s >> 6) + (s & 15);
    return s;
}
__device__ __forceinline__ size_t tiled_off(int row, int k, int nkt) {
    return ((size_t)((row >> 7) * nkt + (k >> 6)) << 13) + (size_t)(lds_byte(row & 127, k & 63) >> 1);
}
struct Unit { int pm, pn; };
struct Gemm { const bf16_t* A; const bf16_t* Bt; int M, N, K, lda, ldb; };
struct StaticOrder {
    int nM, nN, nwg, G, c;
    __device__ void init(int M, int N, int G_, int c_) { nM = M / BM; nN = N / BM; nwg = nM * nN; G = G_; c = c_; }
    __device__ bool next(int i, Unit& u) const {
        const long L = (long)i * G + c; if (L >= nwg) return false;
        int wgid = (int)L; { const int q = nwg / NXCD, r = nwg % NXCD, xcd = wgid % NXCD, off = wgid / NXCD; wgid = (xcd < r ? xcd * (q + 1) : r * (q + 1) + (xcd - r) * q) + off; }
        const int nig = WGM * nN, gid = wgid / nig, fm = gid * WGM, gsz = (nM - fm) < WGM ? (nM - fm) : WGM;
        u.pm = fm + ((wgid % nig) % gsz); u.pn = (wgid % nig) / gsz; return true;
    }
};

template <class Epi>
__device__ __forceinline__ void gemm_phase(LAS unsigned char* lds, const Gemm g, const StaticOrder& S, const Epi& E) {
    const int tid = opaque_tid(), wid = __builtin_amdgcn_readfirstlane(tid >> 6), lane = tid & 63, wr = wid >> 2, wc = wid & 3, fr = lane & 15, fq = lane >> 4;
    const int K = g.K, nt = K / BK;
    unsigned voffA[2], voffB[2];
#pragma unroll
    for (int i = 0; i < 2; ++i) { voffA[i] = (unsigned)(tid * 16 + i * 8192); voffB[i] = voffA[i]; }
    const size_t kstep = (size_t)HTB;
    const size_t hstepA = (size_t)nt * HTB, hstepB = hstepA;
    const size_t tstepA = 2 * hstepA, tstepB = tstepA;
    const unsigned ldsw = (unsigned)wid * 1024u;
    const int aoff = lds_byte(wr * 64 + fr, fq * 8), boff = lds_byte(wc * 32 + fr, fq * 8);
#define PG8_SA(b, h) (((b) * 2 + (h)) * HTB)
#define PG8_SB(b, h) ((4 + (b) * 2 + (h)) * HTB)
#define PG8_STAGE(bufoff, gbase, voff) do { _Pragma("unroll") for (int _i = 0; _i < 2; ++_i) \
        __builtin_amdgcn_global_load_lds((const unsigned*)((const char*)(gbase) + (voff)[_i]), (LAS unsigned*)(lds + (bufoff) + ldsw + _i * 8192), 16, 0, 0); } while (0)
#define PG8_LDA(dst, b, h) do { _Pragma("unroll") for (int m = 0; m < 4; ++m) _Pragma("unroll") for (int k = 0; k < 2; ++k) dst[m][k] = *(const LAS bf16x8*)(lds + PG8_SA(b, h) + aoff + m * 2048 + k * 1024); } while (0)
#define PG8_LDB(dst, b, h) do { _Pragma("unroll") for (int n = 0; n < 2; ++n) _Pragma("unroll") for (int k = 0; k < 2; ++k) dst[n][k] = *(const LAS bf16x8*)(lds + PG8_SB(b, h) + boff + n * 2048 + k * 1024); } while (0)
#define PG8_MMA(ai, bj, At, Bt) do { __builtin_amdgcn_s_setprio(1); _Pragma("unroll") for (int m = 0; m < 4; ++m) _Pragma("unroll") for (int n = 0; n < 2; ++n) _Pragma("unroll") for (int k = 0; k < 2; ++k) \
        acc[ai][bj][m][n] = __builtin_amdgcn_mfma_f32_16x16x32_bf16(Bt[n][k], At[m][k], acc[ai][bj][m][n], 0, 0, 0); __builtin_amdgcn_s_setprio(0); } while (0)
#define PG8_WAIT_V(n) asm volatile("s_waitcnt vmcnt(" #n ")" ::: "memory")
#define PG8_WAIT_L(n) asm volatile("s_waitcnt lgkmcnt(" #n ")" ::: "memory")
#define PG8_BAR __builtin_amdgcn_s_barrier()
#define PG8_SCHED __builtin_amdgcn_sched_barrier(0)
    Unit cur, nxt; int ui = 0;
    if (!S.next(0, cur)) return;
    f32x4 acc[2][2][4][2];
#pragma unroll
    for (int a = 0; a < 2; ++a)
#pragma unroll
        for (int b = 0; b < 2; ++b)
#pragma unroll
            for (int m = 0; m < 4; ++m)
#pragma unroll
                for (int n = 0; n < 2; ++n) acc[a][b][m][n] = (f32x4){0.f, 0.f, 0.f, 0.f};
    bf16x8 At[4][2], B0[2][2], B1[2][2];
    const char* cA = (const char*)g.A + (size_t)cur.pm * tstepA; const char* cB = (const char*)g.Bt + (size_t)cur.pn * tstepB;
    PG8_STAGE(PG8_SB(0, 0), cB, voffB); PG8_STAGE(PG8_SA(0, 0), cA, voffA); PG8_STAGE(PG8_SB(0, 1), cB + hstepB, voffB); PG8_STAGE(PG8_SA(0, 1), cA + hstepA, voffA);
    if (wr == 1) PG8_BAR;
    PG8_WAIT_V(4); PG8_BAR;
    PG8_STAGE(PG8_SB(1, 0), cB + kstep, voffB); PG8_STAGE(PG8_SA(1, 0), cA + kstep, voffA); PG8_STAGE(PG8_SB(1, 1), cB + hstepB + kstep, voffB);
    PG8_WAIT_V(6); PG8_BAR;
    for (;;) {
        const bool has_next = S.next(ui + 1, nxt);
        const char* nA = has_next ? (const char*)g.A + (size_t)nxt.pm * tstepA : cA; const char* nB = has_next ? (const char*)g.Bt + (size_t)nxt.pn * tstepB : cB;
        for (int t = 0; t < nt; t += 2) {
            const bool last = (t == nt - 2);
            const char* a1 = cA + (size_t)(t + 1) * kstep;
            const char* a2 = last ? nA : cA + (size_t)(t + 2) * kstep; const char* b2 = last ? nB : cB + (size_t)(t + 2) * kstep;
            const char* a3 = a2 + kstep; const char* b3 = b2 + kstep;
            PG8_LDB(B0, 0, 0); PG8_SCHED; PG8_LDA(At, 0, 0); PG8_STAGE(PG8_SA(1, 1), a1 + hstepA, voffA);
            PG8_WAIT_L(8); PG8_BAR; PG8_WAIT_L(0); PG8_MMA(0, 0, At, B0); PG8_BAR; PG8_SCHED;
            PG8_LDB(B1, 0, 1); PG8_STAGE(PG8_SB(0, 0), b2, voffB);
            PG8_BAR; PG8_WAIT_L(0); PG8_MMA(0, 1, At, B1); PG8_BAR;
            PG8_LDA(At, 0, 1); PG8_STAGE(PG8_SA(0, 0), a2, voffA);
            PG8_BAR; PG8_WAIT_L(0); PG8_MMA(1, 0, At, B0); PG8_BAR; PG8_SCHED;
            PG8_STAGE(PG8_SB(0, 1), b2 + hstepB, voffB);
            PG8_WAIT_V(6); PG8_BAR; PG8_MMA(1, 1, At, B1); PG8_BAR;
            PG8_LDB(B0, 1, 0); PG8_SCHED; PG8_LDA(At, 1, 0); PG8_STAGE(PG8_SA(0, 1), a2 + hstepA, voffA);
            PG8_WAIT_L(8); PG8_BAR; PG8_WAIT_L(0); PG8_MMA(0, 0, At, B0); PG8_BAR; PG8_SCHED;
            PG8_LDB(B1, 1, 1); PG8_STAGE(PG8_SB(1, 0), b3, voffB);
            PG8_BAR; PG8_WAIT_L(0); PG8_MMA(0, 1, At, B1); PG8_BAR;
            PG8_LDA(At, 1, 1); PG8_STAGE(PG8_SA(1, 0), a3, voffA);
            PG8_BAR; PG8_WAIT_L(0); PG8_MMA(1, 0, At, B0); PG8_BAR; PG8_SCHED;
            PG8_STAGE(PG8_SB(1, 1), b3 + hstepB, voffB);
            PG8_WAIT_V(6); PG8_BAR; PG8_MMA(1, 1, At, B1); PG8_BAR;
        }
        E(acc, cur, wr, wc, fr, fq);
        if (!has_next) break;
#pragma unroll
        for (int a = 0; a < 2; ++a)
#pragma unroll
            for (int b = 0; b < 2; ++b)
#pragma unroll
                for (int m = 0; m < 4; ++m)
#pragma unroll
                    for (int n = 0; n < 2; ++n) acc[a][b][m][n] = (f32x4){0.f, 0.f, 0.f, 0.f};
        cur = nxt; cA = nA; cB = nB; ++ui;
    }
    PG8_WAIT_V(0);
    if (wr == 0) PG8_BAR;
    PG8_BAR;
#undef PG8_SA
#undef PG8_SB
#undef PG8_STAGE
#undef PG8_LDA
#undef PG8_LDB
#undef PG8_MMA
#undef PG8_WAIT_V
#undef PG8_WAIT_L
#undef PG8_BAR
#undef PG8_SCHED
}

struct EpiProj {
    static constexpr int PERM = 2;
    bf16_t* O; const float* cosT; const float* sinT;
    __device__ __forceinline__ void operator()(const f32x4 (&acc)[2][2][4][2], const Unit& u, int wr, int wc, int fr, int fq) const {
        const int row0 = u.pm * BM + wr * 64 + fr, j0 = wc * 16 + 4 * fq, colb = u.pn * BM + j0;
        if (u.pn < 8) {
            const float sc = (u.pn < 4) ? QSCALE : 1.0f;
#pragma unroll
            for (int ai = 0; ai < 2; ++ai) {
                f32x4 csv[4], snv[4];
#pragma unroll
                for (int m = 0; m < 4; ++m) { const int pos = (row0 + ai * HALF + m * 16) & (SEQ - 1); csv[m] = *(const f32x4*)(cosT + pos * 64 + j0); snv[m] = *(const f32x4*)(sinT + pos * 64 + j0); }
#pragma unroll
                for (int m = 0; m < 4; ++m) {
                    const int row = row0 + ai * HALF + m * 16;
                    const f32x4 cs = csv[m], sn = snv[m];
                    bf16_t* rowp = O + (size_t)row * DIN + colb;
#pragma unroll
                    for (int bj = 0; bj < 2; ++bj) {
                        const f32x4 a = acc[ai][bj][m][0], b = acc[ai][bj][m][1];
                        const f32x4 o1 = (a * cs - b * sn) * sc, o2 = (b * cs + a * sn) * sc;
                        u32x2 w1, w2; w1.x = cvt_pk_bf16(o1[0], o1[1]); w1.y = cvt_pk_bf16(o1[2], o1[3]); w2.x = cvt_pk_bf16(o2[0], o2[1]); w2.y = cvt_pk_bf16(o2[2], o2[3]);
                        *(u32x2*)(rowp + bj * HALF) = w1; *(u32x2*)(rowp + bj * HALF + 64) = w2;
                    }
                }
            }
        } else {
#pragma unroll
            for (int ai = 0; ai < 2; ++ai)
#pragma unroll
                for (int m = 0; m < 4; ++m) {
                    const int row = row0 + ai * HALF + m * 16;
                    bf16_t* rowp = O + (size_t)row * DIN + colb;
#pragma unroll
                    for (int bj = 0; bj < 2; ++bj) {
                        const f32x4 o1 = acc[ai][bj][m][0], o2 = acc[ai][bj][m][1];
                        u32x2 w1, w2; w1.x = cvt_pk_bf16(o1[0], o1[1]); w1.y = cvt_pk_bf16(o1[2], o1[3]); w2.x = cvt_pk_bf16(o2[0], o2[1]); w2.y = cvt_pk_bf16(o2[2], o2[3]);
                        *(u32x2*)(rowp + bj * HALF) = w1; *(u32x2*)(rowp + bj * HALF + 64) = w2;
                    }
                }
        }
    }
};
struct EpiRes {
    static constexpr int PERM = 1;
    bf16_t* z; const float* gate;
    const float* stats; const float* lng; const float* lnb;
    __device__ __forceinline__ void operator()(const f32x4 (&acc)[2][2][4][2], const Unit& u, int wr, int wc, int fr, int fq) const {
        const int row0 = u.pm * BM + wr * 64 + fr, col0 = u.pn * BM + wc * 32 + 8 * fq;
        const float* gb = gate + (size_t)(row0 >> 12) * (6 * DM);
        const bool ln = stats != nullptr;
        constexpr int GB[4] = {0, 4, 8, 16};
        f32x2 st[4];
#pragma unroll
        for (int grp = 0; grp < 3; ++grp) {
            u32x4 xv[8]; f32x4 cg[2][2], cl[2][2], cb[2][2];
            if (grp == 0 || grp == 2) {
#pragma unroll
                for (int m = 0; m < 4; ++m) st[m] = ln ? *(const f32x2*)(stats + 2 * (row0 + (grp ? HALF : 0) + m * 16)) : (f32x2){0.f, 1.f};
            }
#pragma unroll
            for (int j = GB[grp]; j < GB[grp + 1]; ++j) {
                const int k = j >> 2, m = j & 3, ai = k >> 1, col = col0 + (k & 1) * HALF, kk = k - (GB[grp] >> 2);
                if (m == 0) {
#pragma unroll
                    for (int n = 0; n < 2; ++n) { cg[kk][n] = *(const f32x4*)(gb + col + 4 * n) + 1.0f; cl[kk][n] = (f32x4){1.f, 1.f, 1.f, 1.f}; cb[kk][n] = (f32x4){0.f, 0.f, 0.f, 0.f};
                        if (ln) { cl[kk][n] = *(const f32x4*)(lng + col + 4 * n); cb[kk][n] = *(const f32x4*)(lnb + col + 4 * n); } }
                }
                xv[j - GB[grp]] = *(const u32x4*)(z + (size_t)(row0 + ai * HALF + m * 16) * DM + col);
            }
#pragma unroll
            for (int j = GB[grp]; j < GB[grp + 1]; ++j) {
                const int k = j >> 2, m = j & 3, ai = k >> 1, bj = k & 1, col = col0 + bj * HALF, kk = k - (GB[grp] >> 2);
                const u32x4 r = xv[j - GB[grp]];
                f32x4 x0 = {bflo(r.x), bfhi(r.x), bflo(r.y), bfhi(r.y)}, x1 = {bflo(r.z), bfhi(r.z), bflo(r.w), bfhi(r.w)};
                x0 = (x0 - st[m].x) * st[m].y * cl[kk][0] + cb[kk][0]; x1 = (x1 - st[m].x) * st[m].y * cl[kk][1] + cb[kk][1];
                const f32x4 o0 = x0 * ALPHA + cg[kk][0] * acc[ai][bj][m][0], o1 = x1 * ALPHA + cg[kk][1] * acc[ai][bj][m][1];
                u32x4 w; w.x = cvt_pk_bf16(o0[0], o0[1]); w.y = cvt_pk_bf16(o0[2], o0[3]); w.z = cvt_pk_bf16(o1[0], o1[1]); w.w = cvt_pk_bf16(o1[2], o1[3]);
                *(u32x4*)(z + (size_t)(row0 + ai * HALF + m * 16) * DM + col) = w;
            }
        }
    }
};
struct EpiFF1 {
    static constexpr int PERM = 1;
    bf16_t* O;
    __device__ __forceinline__ void operator()(const f32x4 (&acc)[2][2][4][2], const Unit& u, int wr, int wc, int fr, int fq) const {
        const int row0 = u.pm * BM + wr * 64 + fr, col0 = u.pn * BM + wc * 32 + 8 * fq;
#pragma unroll
        for (int ai = 0; ai < 2; ++ai)
#pragma unroll
            for (int m = 0; m < 4; ++m) {
                const int rowi = row0 + ai * HALF + m * 16;
#pragma unroll
                for (int bj = 0; bj < 2; ++bj) {
                    f32x4 v0 = acc[ai][bj][m][0], v1 = acc[ai][bj][m][1];
#pragma unroll
                    for (int j = 0; j < 4; ++j) { const float a = fmaxf(v0[j], 0.f), b = fmaxf(v1[j], 0.f); v0[j] = a * a; v1[j] = b * b; }
                    u32x4 w; w.x = cvt_pk_bf16(v0[0], v0[1]); w.y = cvt_pk_bf16(v0[2], v0[3]); w.z = cvt_pk_bf16(v1[0], v1[1]); w.w = cvt_pk_bf16(v1[2], v1[3]);
                    *(u32x4*)(O + tiled_off(rowi, col0 + bj * HALF, DFF / 64)) = w;
                }
            }
    }
};
}

__device__ __forceinline__ void pro_a_phase(const Params& p, LAS unsigned char* lds) {
    const int tid = opaque_tid();
    LAS float* cond = (LAS float*)lds;
    LAS float* red = (LAS float*)(lds + 32768);
    LAS float* tile = (LAS float*)(lds + 65536);
    float* mod = (float*)(p.ws + WS_MOD);
    const int G = gridDim.x;
    constexpr int N_GEMV = 256, N_ROPE = 512, N_TR = 12288, FIRST_TR = N_GEMV + N_ROPE;
    if ((int)blockIdx.x < N_GEMV) {
        for (int i = tid; i < 4 * DM; i += 512) { const float v = p.c[i]; cond[i] = v / (1.0f + __expf(-v)); }
        __syncthreads();
    }
    int item = blockIdx.x;
    for (; item < FIRST_TR; item += G) {
        if (item < N_GEMV) {
            const int l = item >> 7, n0 = (item & 127) * 96, cq = tid & 31, kg = tid >> 5;
            const float* wp = p.w_mod + (size_t)l * DM * (6 * DM) + (size_t)(kg * 128) * (6 * DM) + n0 + cq * 4;
            const LAS float* cp = cond + kg * 128;
            f32x4 a0 = {0.f, 0.f, 0.f, 0.f}, a1 = a0, a2 = a0, a3 = a0;
            if (cq < 24)
#pragma unroll 8
            for (int k = 0; k < 128; ++k) {
                const f32x4 w = __builtin_nontemporal_load((const f32x4*)(wp + (size_t)k * (6 * DM)));
                a0 += w * cp[k]; a1 += w * cp[DM + k]; a2 += w * cp[2 * DM + k]; a3 += w * cp[3 * DM + k];
            }
            *(LAS f32x4*)(red + (kg * 4 + 0) * 128 + cq * 4) = a0; *(LAS f32x4*)(red + (kg * 4 + 1) * 128 + cq * 4) = a1;
            *(LAS f32x4*)(red + (kg * 4 + 2) * 128 + cq * 4) = a2; *(LAS f32x4*)(red + (kg * 4 + 3) * 128 + cq * 4) = a3;
            __syncthreads();
            { const int b = tid >> 7, col = tid & 127;
              if (col < 96) { float s = p.b_mod[l * 6 * DM + n0 + col];
#pragma unroll
                for (int k2 = 0; k2 < 16; ++k2) s += red[(k2 * 4 + b) * 128 + col];
                mod[((size_t)l * 4 + b) * (6 * DM) + n0 + col] = s; } }
            __syncthreads();
        } else {
            const int idx = (item - N_GEMV) * 512 + tid, pos = idx >> 6, j = idx & 63;
            double invd = 1.0;
#pragma nounroll
            for (int k = 0; k < j; ++k) invd *= 0.86596432336006535;
            const float inv = (float)invd;
            const float ang = (float)pos * inv;
            const double xd = (double)ang, kk = rint(xd * 0.15915494309189535), y = xd - kk * 6.283185307179586, y2 = y * y;
            double s = 1.0, c = 1.0;
#pragma nounroll
            for (int k = 13; k >= 1; --k) { s = 1.0 - s * y2 / (double)((2 * k) * (2 * k + 1)); c = 1.0 - c * y2 / (double)((2 * k - 1) * (2 * k)); }
            ((float*)(p.ws + WS_COS))[idx] = (float)c; ((float*)(p.ws + WS_SIN))[idx] = (float)(y * s);
        }
    }
    auto decode = [&](int tt, const float*& src, bf16_t*& dst, int& K, int& N, int& mode, int& n0, int& k0) {
        const int l = tt / 6144, u = tt % 6144; int v;
        if (u < 1536) { mode = 2; K = DM; N = DIN; v = u; src = p.w_in + (size_t)l * DM * DIN; dst = (bf16_t*)(p.ws + WS_WT_IN) + (size_t)l * DIN * LDU; }
        else if (u < 2048) { mode = 1; K = DM; N = DM; v = u - 1536; src = p.w_out + (size_t)l * DM * DM; dst = (bf16_t*)(p.ws + WS_WT_OUT) + (size_t)l * DM * LDU; }
        else if (u < 4096) { mode = 1; K = DM; N = DFF; v = u - 2048; src = p.w_ff1 + (size_t)l * DM * DFF; dst = (bf16_t*)(p.ws + WS_WT_FF1) + (size_t)l * DFF * LDU; }
        else { mode = 1; K = DFF; N = DM; v = u - 4096; src = p.w_ff2 + (size_t)l * DFF * DM; dst = (bf16_t*)(p.ws + WS_WT_FF2) + (size_t)l * DM * LDH; }
        const int ntn = N >> 6, kt = v / ntn, nt = v % ntn;
        src += (size_t)(kt * 128) * N + nt * 64; n0 = nt * 64; k0 = kt * 128;
    };
    const int lk = tid >> 4, ln4 = tid & 15;
    const int sn = tid >> 4, skc = tid & 15;
    int tt = item - FIRST_TR;
    if (tt < N_TR) {
        const float* src; bf16_t* dst; int K, N, mode, n0, k0; decode(tt, src, dst, K, N, mode, n0, k0);
        f32x4 rg[4];
#pragma unroll
        for (int i = 0; i < 4; ++i) rg[i] = __builtin_nontemporal_load((const f32x4*)(src + (size_t)(lk + 32 * i) * N + ln4 * 4));
        for (;;) {
#pragma unroll
            for (int i = 0; i < 4; ++i) { LAS float* tp = tile + (lk + 32 * i) * 65 + ln4 * 4; tp[0] = rg[i][0]; tp[1] = rg[i][1]; tp[2] = rg[i][2]; tp[3] = rg[i][3]; }
            asm volatile("s_waitcnt lgkmcnt(0)" ::: "memory"); __builtin_amdgcn_s_barrier(); asm volatile("" ::: "memory");
            bf16_t* cdst = dst; const int cnkt = K >> 6, cmode = mode, cn0 = n0, ck0 = k0;
            const int tn = tt + G;
            if (tn < N_TR) { decode(tn, src, dst, K, N, mode, n0, k0);
#pragma unroll
                for (int i = 0; i < 4; ++i) rg[i] = __builtin_nontemporal_load((const f32x4*)(src + (size_t)(lk + 32 * i) * N + ln4 * 4)); }
#pragma unroll
            for (int i = 0; i < 2; ++i) {
                const int n = sn + 32 * i; const LAS float* tp = tile + (skc * 8) * 65 + n;
                u32x4 w; w.x = cvt_pk_bf16(tp[0], tp[65]); w.y = cvt_pk_bf16(tp[130], tp[195]); w.z = cvt_pk_bf16(tp[260], tp[325]); w.w = cvt_pk_bf16(tp[390], tp[455]);
                const int ng = cn0 + n, np = (ng & ~127) + pg8::bperm_inv(cmode, ng & 127);
                *(u32x4*)(cdst + pg8::tiled_off(np, ck0 + skc * 8, cnkt)) = w;
            }
            asm volatile("s_waitcnt lgkmcnt(0)" ::: "memory"); __builtin_amdgcn_s_barrier(); asm volatile("" ::: "memory");
            if (tn >= N_TR) break;
            tt = tn;
        }
    }
}

template <bool DO_LN>
__device__ __forceinline__ void row_phase(const float* xin, bf16_t* zb, float* xout, const float* g, const float* bta, const float* modl, int sc_off, int sh_off, bf16_t* U, float* stats, int rbase) {
    const int tid = opaque_tid(), wid = tid >> 6, lane = tid & 63;
    const int rstep = rbase >= 0 ? 8 : (int)gridDim.x * 8, rend = rbase >= 0 ? rbase + 64 : T_TOK;
    f32x4 vn[8]; u32x2 vb[8];
    int row = (rbase >= 0 ? rbase : (int)blockIdx.x * 8) + wid;
    if (row < rend) {
#pragma unroll
        for (int i = 0; i < 8; ++i) { if (DO_LN) vb[i] = *(const u32x2*)(zb + (size_t)row * DM + lane * 4 + i * 256); else vn[i] = __builtin_nontemporal_load((const f32x4*)(xin + (size_t)row * DM + lane * 4 + i * 256)); }
    }
    for (; row < rend; row += rstep) {
        f32x4 v[8], scv[8], shv[8];
#pragma unroll
        for (int i = 0; i < 8; ++i) { if (DO_LN) v[i] = (f32x4){bflo(vb[i].x), bfhi(vb[i].x), bflo(vb[i].y), bfhi(vb[i].y)}; else v[i] = vn[i]; }
        { const int nrow = row + rstep;
          if (nrow < rend) {
#pragma unroll
              for (int i = 0; i < 8; ++i) { if (DO_LN) vb[i] = *(const u32x2*)(zb + (size_t)nrow * DM + lane * 4 + i * 256); else vn[i] = __builtin_nontemporal_load((const f32x4*)(xin + (size_t)nrow * DM + lane * 4 + i * 256)); }
          } }
        if (DO_LN) {
            float s = 0.f;
#pragma unroll
            for (int i = 0; i < 8; ++i) s += (v[i][0] + v[i][1]) + (v[i][2] + v[i][3]);
#pragma unroll
            for (int o = 32; o >= 1; o >>= 1) s += __shfl_xor(s, o);
            const float mu = s * (1.0f / DM);
            float q = 0.f;
#pragma unroll
            for (int i = 0; i < 8; ++i) { v[i] -= mu; q += (v[i][0] * v[i][0] + v[i][1] * v[i][1]) + (v[i][2] * v[i][2] + v[i][3] * v[i][3]); }
#pragma unroll
            for (int o = 32; o >= 1; o >>= 1) q += __shfl_xor(q, o);
            const float rstd = rsqrtf(q * (1.0f / DM) + 1e-5f);
            const unsigned voff = (unsigned)lane * 16u;
            {
                f32x4 gg[8], bb[8];
#pragma unroll
                for (int i = 0; i < 8; ++i) { gg[i] = *(const f32x4*)((const char*)g + (voff + (unsigned)i * 1024u)); bb[i] = *(const f32x4*)((const char*)bta + (voff + (unsigned)i * 1024u)); }
#pragma unroll
                for (int i = 0; i < 8; ++i) v[i] = v[i] * rstd * gg[i] + bb[i];
            }
            if (U) {
                const char* mb = (const char*)(modl + (size_t)(row >> 12) * (6 * DM));
#pragma unroll
                for (int i = 0; i < 8; ++i) { scv[i] = *(const f32x4*)(mb + ((unsigned)sc_off * 4u + voff + (unsigned)i * 1024u)); shv[i] = *(const f32x4*)(mb + ((unsigned)sh_off * 4u + voff + (unsigned)i * 1024u)); }
            }
            if (stats) { if (lane == 0) *(f32x2*)(stats + 2 * row) = (f32x2){mu, rstd}; }
            else {
                float* op = xout + (size_t)row * DM + lane * 4;
#pragma unroll
                for (int i = 0; i < 8; ++i) __builtin_nontemporal_store(v[i], (f32x4*)(op + i * 256));
            }
        }
        if (U) {
            if (!DO_LN) {
                const unsigned voff = (unsigned)lane * 16u;
                const char* mb = (const char*)(modl + (size_t)(row >> 12) * (6 * DM));
#pragma unroll
                for (int i = 0; i < 8; ++i) { scv[i] = *(const f32x4*)(mb + ((unsigned)sc_off * 4u + voff + (unsigned)i * 1024u)); shv[i] = *(const f32x4*)(mb + ((unsigned)sh_off * 4u + voff + (unsigned)i * 1024u)); }
            }
#pragma unroll
            for (int i = 0; i < 8; ++i) {
                const f32x4 uu = v[i] * (scv[i] + 1.0f) + shv[i];
                u32x2 w; w.x = cvt_pk_bf16(uu[0], uu[1]); w.y = cvt_pk_bf16(uu[2], uu[3]);
                *(u32x2*)(U + pg8::tiled_off(row, i * 256 + lane * 4, DM / 64)) = w;
                if (!DO_LN) { u32x2 wz; wz.x = cvt_pk_bf16(v[i][0], v[i][1]); wz.y = cvt_pk_bf16(v[i][2], v[i][3]); *(u32x2*)(zb + (size_t)row * DM + lane * 4 + i * 256) = wz; }
            }
        }
    }
}

struct AttnStep { size_t tb; int h, dl, r, n, br, first; };
__device__ __forceinline__ AttnStep attn_step(int wg, int q, int mode) {
    AttnStep a;
    if (mode) { const int bh = wg >> 3; a.tb = (size_t)(bh >> 3) * SEQ; a.h = bh & 7; a.br = 0; a.dl = 0; a.r = 0; a.n = 4 * (wg & 7) + q; a.first = (q == 0); }
    else if (wg < 128) { a.tb = (size_t)(wg >> 5) * SEQ; a.h = (wg >> 2) & 7; a.br = 1; a.dl = 2; a.r = wg & 3; a.n = q; a.first = (q == 0); }
    else { const int c16 = (wg - 128) * 4 + (q >> 1); a.tb = (size_t)(c16 >> 7) * SEQ; a.h = (c16 >> 4) & 7; a.br = 2; a.dl = 4; a.r = c16 & 15; a.n = q & 1; a.first = !(q & 1); }
    return a;
}
__device__ __forceinline__ void attn_phase(const Params& p, LAS unsigned char* lds, int l, int mode) {
    const bf16_t* proj = (const bf16_t*)(p.ws + WS_PROJ);
    bf16_t* opart = (bf16_t*)(p.ws + WS_OPART); float* lse = (float*)(p.ws + WS_LSE);
    bf16_t* mixed = (bf16_t*)(p.ws + WS_U);
    const float* gain = p.mix_g + (size_t)l * DM;
    const int tid = opaque_tid(), wid = tid >> 6, lane = tid & 63, li = lane & 15, g = lane >> 4;
    LAS unsigned char* Kl = lds; LAS unsigned char* Vl = lds + 256 * 272;
    constexpr int KH = 128 * 272, VH = 128 * 288;
    const int nsteps = mode ? 4 : 8;
    u32x4 kv[4], vv[4]; bf16x8 qf[4];
#define ATTN_LOAD_BLK(A, NB) do { _Pragma("unroll") for (int i = 0; i < 4; ++i) { const int idx = tid + 512 * i, row = idx >> 4, ch = idx & 15; \
            const bf16_t* src = proj + ((A).tb + ((size_t)((NB) * 128 + row) << (A).dl) + (A).r) * DIN + (A).h * 128 + ch * 8; kv[i] = *(const u32x4*)(src + 1024); vv[i] = *(const u32x4*)(src + 2048); } } while (0)
#define ATTN_STORE_BLK(HH) do { _Pragma("unroll") for (int i = 0; i < 4; ++i) { const int idx = tid + 512 * i, row = idx >> 4, ch = idx & 15; \
            *(LAS u32x4*)(Kl + (HH) * KH + row * 272 + ch * 16) = kv[i]; *(LAS u32x4*)(Vl + (HH) * VH + row * 288 + ch * 16) = vv[i]; } } while (0)
#define ATTN_LOAD_Q(A) do { const size_t qt_ = (A).tb + ((size_t)((A).n * 128 + wid * 16 + li) << (A).dl) + (A).r; \
            _Pragma("unroll") for (int s = 0; s < 4; ++s) qf[s] = *(const bf16x8*)(proj + qt_ * DIN + (A).h * 128 + s * 32 + g * 8); } while (0)
    for (int wg = blockIdx.x; wg < 256; wg += gridDim.x) {
        AttnStep cur = attn_step(wg, 0, mode);
        if (mode && cur.n > 0) { ATTN_LOAD_BLK(cur, cur.n - 1); ATTN_STORE_BLK(1); }
        ATTN_LOAD_BLK(cur, cur.n); ATTN_LOAD_Q(cur);
        for (int q = 0; q < nsteps; ++q) {
            const int c = q & 1;
            if (cur.first && cur.n == 0) {
#pragma unroll
                for (int i = 0; i < 4; ++i) { const int idx = tid + 512 * i, row = idx >> 4, ch = idx & 15;
                    *(LAS u32x4*)(Kl + (c ^ 1) * KH + row * 272 + ch * 16) = (u32x4){0u, 0u, 0u, 0u}; *(LAS u32x4*)(Vl + (c ^ 1) * VH + row * 288 + ch * 16) = (u32x4){0u, 0u, 0u, 0u}; }
            }
            ATTN_STORE_BLK(c);
            bf16x8 qc[4];
#pragma unroll
            for (int s = 0; s < 4; ++s) qc[s] = qf[s];
            asm volatile("s_waitcnt lgkmcnt(0)" ::: "memory"); __builtin_amdgcn_s_barrier(); asm volatile("" ::: "memory");
            AttnStep nxt = attn_step(wg, (q + 1 < nsteps) ? q + 1 : q, mode);
            if (q + 1 < nsteps) { ATTN_LOAD_BLK(nxt, nxt.n); ATTN_LOAD_Q(nxt); }
            const int n = cur.n, dl = cur.dl, h = cur.h, mbase = (n - 1) * 128;
            const int qi = wid * 16 + li; const size_t qtok = cur.tb + ((size_t)(n * 128 + qi) << dl) + cur.r;
            const int kb0 = wid & ~1;
            const int koffP = (c ^ 1) * KH, koffC = c * KH, voffP = (c ^ 1) * VH, voffC = c * VH;
            f32x4 sacc[10];
#pragma unroll
            for (int i = 0; i < 10; ++i) {
                sacc[i] = (f32x4){0.f, 0.f, 0.f, 0.f};
                const int kb = kb0 + i, koff = (kb < 8) ? koffP + kb * (16 * 272) : koffC + (kb - 8) * (16 * 272);
#pragma unroll
                for (int s = 0; s < 4; ++s) {
                    const bf16x8 kf = *(const LAS bf16x8*)(Kl + koff + li * 272 + (32 * s + 8 * g) * 2);
                    sacc[i] = __builtin_amdgcn_mfma_f32_16x16x32_bf16(kf, qc[s], sacc[i], 0, 0, 0);
                }
            }
            float mx = -1e30f;
#pragma unroll
            for (int i = 0; i < 10; ++i)
#pragma unroll
                for (int j = 0; j < 4; ++j) {
                    const int kj = 16 * (kb0 + i) + 4 * g + j, dist = 128 + qi - kj;
                    const bool valid = (dist >= 0) && (dist <= 128) && (mbase + kj >= 0);
                    const float sv = valid ? sacc[i][j] : -1e30f;
                    sacc[i][j] = sv; mx = fmaxf(mx, sv);
                }
            mx = fmaxf(mx, __shfl_xor(mx, 16)); mx = fmaxf(mx, __shfl_xor(mx, 32));
            float lsum = 0.f;
#pragma unroll
            for (int i = 0; i < 10; ++i)
#pragma unroll
                for (int j = 0; j < 4; ++j) { const float pv = __builtin_amdgcn_exp2f(sacc[i][j] - mx); sacc[i][j] = pv; lsum += pv; }
            lsum += __shfl_xor(lsum, 16); lsum += __shfl_xor(lsum, 32);
            u32x2 x1[8], x2[8]; float l1 = 0.f, l2 = 0.f;
            if (mode) {
                l1 = lse[qtok * 8 + h]; l2 = lse[((size_t)T_TOK + qtok) * 8 + h];
                const bf16_t* p1 = opart + qtok * 1024 + h * 128 + 4 * g; const bf16_t* p2 = p1 + (size_t)T_TOK * 1024;
#pragma unroll
                for (int db = 0; db < 8; ++db) { x1[db] = *(const u32x2*)(p1 + 16 * db); x2[db] = *(const u32x2*)(p2 + 16 * db); }
            }
            f32x4 oacc[8];
#pragma unroll
            for (int db = 0; db < 8; ++db) oacc[db] = (f32x4){0.f, 0.f, 0.f, 0.f};
            const int vlane = (4 * g + (li >> 2)) * 288 + (4 * (li & 3)) * 2;
#pragma unroll
            for (int t = 0; t < 5; ++t) {
                u32x4 pw; pw.x = cvt_pk_bf16(sacc[2 * t][0], sacc[2 * t][1]); pw.y = cvt_pk_bf16(sacc[2 * t][2], sacc[2 * t][3]);
                pw.z = cvt_pk_bf16(sacc[2 * t + 1][0], sacc[2 * t + 1][1]); pw.w = cvt_pk_bf16(sacc[2 * t + 1][2], sacc[2 * t + 1][3]);
                const bf16x8 pf = __builtin_bit_cast(bf16x8, pw);
                const int kbv = kb0 + 2 * t, voff = (kbv < 8) ? voffP + kbv * (16 * 288) : voffC + (kbv - 8) * (16 * 288);
                const LAS unsigned char* vb = Vl + voff + vlane;
#pragma unroll
                for (int db = 0; db < 8; ++db) {
                    const s16x4 lo = __builtin_bit_cast(s16x4, __builtin_amdgcn_ds_read_tr16_b64_v4i16((LAS s16x4*)(vb + db * 32)));
                    const s16x4 hi = __builtin_bit_cast(s16x4, __builtin_amdgcn_ds_read_tr16_b64_v4i16((LAS s16x4*)(vb + 16 * 288 + db * 32)));
                    const bf16x8 vf = __builtin_shufflevector(lo, hi, 0, 1, 2, 3, 4, 5, 6, 7);
                    oacc[db] = __builtin_amdgcn_mfma_f32_16x16x32_bf16(vf, pf, oacc[db], 0, 0, 0);
                }
            }
            const float inv = 1.0f / lsum, lse0 = mx + __builtin_amdgcn_logf(lsum);
            if (mode == 0) {
                bf16_t* op = opart + ((size_t)(cur.br - 1) * T_TOK + qtok) * 1024 + h * 128 + 4 * g;
#pragma unroll
                for (int db = 0; db < 8; ++db) { const f32x4 o = oacc[db] * inv; u32x2 w; w.x = cvt_pk_bf16(o[0], o[1]); w.y = cvt_pk_bf16(o[2], o[3]); *(u32x2*)(op + 16 * db) = w; }
                if (g == 0) lse[((size_t)(cur.br - 1) * T_TOK + qtok) * 8 + h] = lse0;
            } else {
                const float lm = fmaxf(lse0, fmaxf(l1, l2));
                const float w0 = __builtin_amdgcn_exp2f(lse0 - lm), w1 = __builtin_amdgcn_exp2f(l1 - lm), w2 = __builtin_amdgcn_exp2f(l2 - lm);
                const float wi = 1.0f / (w0 + w1 + w2), a0 = w0 * wi * inv, a1 = w1 * wi, a2 = w2 * wi;
                float ss = 0.f;
#pragma unroll
                for (int db = 0; db < 8; ++db) {
                    f32x4 o = oacc[db] * a0;
                    o[0] += bflo(x1[db].x) * a1 + bflo(x2[db].x) * a2; o[1] += bfhi(x1[db].x) * a1 + bfhi(x2[db].x) * a2;
                    o[2] += bflo(x1[db].y) * a1 + bflo(x2[db].y) * a2; o[3] += bfhi(x1[db].y) * a1 + bfhi(x2[db].y) * a2;
                    oacc[db] = o; ss += (o[0] * o[0] + o[1] * o[1]) + (o[2] * o[2] + o[3] * o[3]);
                }
                ss += __shfl_xor(ss, 16); ss += __shfl_xor(ss, 32);
                const float rs = rsqrtf(ss * (1.0f / 128.0f) + 1e-6f);
                f32x4 ggv[8];
#pragma unroll
                for (int db = 0; db < 8; ++db) ggv[db] = *(const f32x4*)(gain + h * 128 + 16 * db + 4 * g);
#pragma unroll
                for (int db = 0; db < 8; ++db) {
                    const f32x4 gg = ggv[db];
                    const f32x4 o = oacc[db] * rs * gg;
                    u32x2 w; w.x = cvt_pk_bf16(o[0], o[1]); w.y = cvt_pk_bf16(o[2], o[3]);
                    *(u32x2*)(mixed + pg8::tiled_off((int)qtok, h * 128 + 16 * db + 4 * g, DM / 64)) = w;
                }
            }
            asm volatile("s_waitcnt lgkmcnt(0)" ::: "memory"); __builtin_amdgcn_s_barrier(); asm volatile("" ::: "memory");
            cur = nxt;
        }
    }
#undef ATTN_LOAD_BLK
#undef ATTN_STORE_BLK
#undef ATTN_LOAD_Q
}

__device__ __forceinline__ void conv_phase(const Params& p, int l) {
    const bf16_t* proj = (const bf16_t*)(p.ws + WS_PROJ);
    bf16_t* mixed = (bf16_t*)(p.ws + WS_U);
    const float* gain = p.mix_g + (size_t)l * DM; const float* cw = p.conv_w + (size_t)l * 3 * 1024;
    const int tid = opaque_tid(), wid = tid >> 6, lane = tid & 63;
    u32x2 ngb[4], ngc0[4], nhi0[4], ngc1[4], nhi1[4], ngc2[4], nhi2[4];
#define CONV_LOAD(T) do { const int pos_ = (T) & (SEQ - 1); _Pragma("unroll") for (int i = 0; i < 4; ++i) { \
            const bf16_t* pr = proj + (size_t)(T) * DIN + i * 256 + lane * 4; \
            ngb[i] = *(const u32x2*)(pr + 3072); ngc0[i] = *(const u32x2*)(pr + 4096); nhi0[i] = *(const u32x2*)(pr + 5120); \
            ngc1[i] = (u32x2){0u, 0u}; nhi1[i] = ngc1[i]; ngc2[i] = ngc1[i]; nhi2[i] = ngc1[i]; \
            if (pos_ >= 1) { ngc1[i] = *(const u32x2*)(pr - DIN + 4096); nhi1[i] = *(const u32x2*)(pr - DIN + 5120); } \
            if (pos_ >= 2) { ngc2[i] = *(const u32x2*)(pr - 2 * DIN + 4096); nhi2[i] = *(const u32x2*)(pr - 2 * DIN + 5120); } } } while (0)
    int t = blockIdx.x * 8 + wid;
    if (t < T_TOK) CONV_LOAD(t);
    for (; t < T_TOK; t += gridDim.x * 8) {
        u32x2 gb[4], gc0[4], hi0[4], gc1[4], hi1[4], gc2[4], hi2[4];
#pragma unroll
        for (int i = 0; i < 4; ++i) { gb[i] = ngb[i]; gc0[i] = ngc0[i]; hi0[i] = nhi0[i]; gc1[i] = ngc1[i]; hi1[i] = nhi1[i]; gc2[i] = ngc2[i]; hi2[i] = nhi2[i]; }
        { const int tn = t + gridDim.x * 8; if (tn < T_TOK) CONV_LOAD(tn); }
        f32x4 cw0[4], cw1[4], cw2[4], g2[4];
#pragma unroll
        for (int i = 0; i < 4; ++i) { const int col = i * 256 + lane * 4;
            cw0[i] = *(const f32x4*)(cw + col); cw1[i] = *(const f32x4*)(cw + 1024 + col); cw2[i] = *(const f32x4*)(cw + 2048 + col); g2[i] = *(const f32x4*)(gain + 1024 + col); }
#pragma unroll
        for (int i = 0; i < 4; ++i) {
            const int col = i * 256 + lane * 4;
            f32x4 c0, c1, c2, gbv;
            c0[0] = bflo(gc0[i].x) * bflo(hi0[i].x); c0[1] = bfhi(gc0[i].x) * bfhi(hi0[i].x); c0[2] = bflo(gc0[i].y) * bflo(hi0[i].y); c0[3] = bfhi(gc0[i].y) * bfhi(hi0[i].y);
            c1[0] = bflo(gc1[i].x) * bflo(hi1[i].x); c1[1] = bfhi(gc1[i].x) * bfhi(hi1[i].x); c1[2] = bflo(gc1[i].y) * bflo(hi1[i].y); c1[3] = bfhi(gc1[i].y) * bfhi(hi1[i].y);
            c2[0] = bflo(gc2[i].x) * bflo(hi2[i].x); c2[1] = bfhi(gc2[i].x) * bfhi(hi2[i].x); c2[2] = bflo(gc2[i].y) * bflo(hi2[i].y); c2[3] = bfhi(gc2[i].y) * bfhi(hi2[i].y);
            gbv[0] = bflo(gb[i].x); gbv[1] = bfhi(gb[i].x); gbv[2] = bflo(gb[i].y); gbv[3] = bfhi(gb[i].y);
            f32x4 y = gbv * (cw0[i] * c2 + cw1[i] * c1 + cw2[i] * c0);
            float s2 = (y[0] * y[0] + y[1] * y[1]) + (y[2] * y[2] + y[3] * y[3]);
#pragma unroll
            for (int sft = 16; sft >= 1; sft >>= 1) s2 += __shfl_xor(s2, sft);
            const float rs2 = rsqrtf(s2 * (1.0f / 128.0f) + 1e-6f);
            y = y * rs2 * g2[i];
            u32x2 wy; wy.x = cvt_pk_bf16(y[0], y[1]); wy.y = cvt_pk_bf16(y[2], y[3]);
            *(u32x2*)(mixed + pg8::tiled_off(t, 1024 + col, DM / 64)) = wy;
        }
    }
#undef CONV_LOAD
}

#define XB_TMO      128
#define XB_XCNT(j)  (256  + 64 * (j))
#define XB_XSUB(j)  (1280 + 64 * (j))
#define XB_XGEN(j)  (2304 + 64 * (j))
#define XB_TOP      3328
#define XB_TOPGEN   3392
#define XB_LSUB(j)  (3456 + 64 * (j))
#define XB_LGEN(j)  (3968 + 64 * (j))
#define XCD_BAR_WORDS 4480
#define XB_SPIN_CAP (1u << 22)
__device__ __forceinline__ unsigned xb_ld(unsigned* p)              { return __hip_atomic_load(p, __ATOMIC_RELAXED, __HIP_MEMORY_SCOPE_AGENT); }
__device__ __forceinline__ unsigned xb_add(unsigned* p, unsigned v) { return __hip_atomic_fetch_add(p, v, __ATOMIC_RELAXED, __HIP_MEMORY_SCOPE_AGENT); }
#define XB_SPIN(cond, bar) do { unsigned _sp = 0; while (cond) { __builtin_amdgcn_s_sleep(1); \
    if ((++_sp & 255u) == 0u) { if (xb_ld(&(bar)[XB_TMO])) break; if (_sp > XB_SPIN_CAP) { atomicAdd(&(bar)[XB_TMO], 1u); break; } } } } while (0)
struct XcdBarrier { unsigned* bar; unsigned x; volatile LAS unsigned* st; };
__device__ __forceinline__ void xcd_barrier_complete(unsigned* bar, unsigned x, unsigned& nloc, unsigned& nx) {
    const unsigned G = gridDim.x * gridDim.y * gridDim.z;
    unsigned sum, cnt, mine, sp = 0u;
    for (;;) {
        sum = 0u; cnt = 0u; mine = 0u;
#pragma unroll
        for (unsigned j = 0; j < 16; ++j) { const unsigned c = xb_ld(&bar[XB_XCNT(j)]); sum += c; cnt += (c > 0u) ? 1u : 0u; mine = (j == x) ? c : mine; }
        if (sum == G) break;
        __builtin_amdgcn_s_sleep(1);
        if ((++sp & 255u) == 0u) { if (xb_ld(&bar[XB_TMO])) break; if (sp > XB_SPIN_CAP) { atomicAdd(&bar[XB_TMO], 1u); break; } }
    }
    nloc = mine > 0u ? mine : 1u; nx = cnt > 0u ? cnt : 1u;
}
__device__ __forceinline__ void xcd_barrier(const XcdBarrier& b) {
    asm volatile("s_waitcnt vmcnt(0)" ::: "memory");
    __syncthreads();
    if (threadIdx.x == 0) {
        unsigned* bar = b.bar;
        __builtin_amdgcn_s_waitcnt(0);
        unsigned nloc = b.st[0], nx = b.st[1];
        if (nloc == 0u) { xcd_barrier_complete(bar, b.x, nloc, nx); b.st[0] = nloc; b.st[1] = nx; }
        const unsigned old = xb_add(&bar[XB_XSUB(b.x)], 1u);
        const unsigned gen = old / nloc;
        if (old + 1u == (gen + 1u) * nloc) {
            __builtin_amdgcn_fence(__ATOMIC_RELEASE, "agent");
            asm volatile("s_waitcnt vmcnt(0)" ::: "memory");
            const unsigned og = xb_add(&bar[XB_TOP], 1u);
            const unsigned tg = og / nx;
            if (og + 1u == (tg + 1u) * nx) xb_add(&bar[XB_TOPGEN], 1u);
            else XB_SPIN(xb_ld(&bar[XB_TOPGEN]) == tg, bar);
            __builtin_amdgcn_fence(__ATOMIC_ACQUIRE, "agent");
            xb_add(&bar[XB_XGEN(b.x)], 1u);
            asm volatile("s_waitcnt vmcnt(0)" ::: "memory");
        } else {
            XB_SPIN(xb_ld(&bar[XB_XGEN(b.x)]) == gen, bar);
            __builtin_amdgcn_fence(__ATOMIC_ACQUIRE, "agent");
            asm volatile("s_waitcnt vmcnt(0)" ::: "memory");
        }
    }
    __syncthreads();
}

__device__ __forceinline__ void xcd_local_barrier(const XcdBarrier& b, unsigned nloc) {
    asm volatile("s_waitcnt vmcnt(0)" ::: "memory");
    __syncthreads();
    if (threadIdx.x == 0) {
        unsigned* bar = b.bar;
        __builtin_amdgcn_s_waitcnt(0);
        const unsigned old = xb_add(&bar[XB_LSUB(b.x)], 1u);
        const unsigned gen = old / nloc;
        if (old + 1u == (gen + 1u) * nloc) xb_add(&bar[XB_LGEN(b.x)], 1u);
        else XB_SPIN(xb_ld(&bar[XB_LGEN(b.x)]) == gen, bar);
        __builtin_amdgcn_fence(__ATOMIC_ACQUIRE, "agent");
        asm volatile("s_waitcnt vmcnt(0)" ::: "memory");
    }
    __syncthreads();
}

__global__ void __launch_bounds__(512, 2) fwd_megakernel(Params p) {
    extern __shared__ __attribute__((aligned(16))) unsigned char shm[];
    LAS unsigned char* lds = (LAS unsigned char*)shm;
    const float* mod = (const float*)(p.ws + WS_MOD);
    bf16_t* zb = (bf16_t*)(p.ws + WS_ZB);
    int vc = blockIdx.x, myrank = 0; bool xlocal = false;
    unsigned* bar = (unsigned*)(p.ws + WS_CTL);
    XcdBarrier xb; xb.bar = bar; xb.x = (unsigned)__builtin_amdgcn_s_getreg((3 << 11) | 20) & 0xFu; xb.st = (volatile LAS unsigned*)(lds + LDS_ST);
    const bool fused = (p.ph_hi - p.ph_lo) > 1;
    if (p.never) cg::this_grid().sync();
    if (fused) {
        if (threadIdx.x == 0) { xb.st[0] = 0u; xb.st[1] = 0u; xb.st[2] = xb_add(&bar[XB_XCNT(xb.x)], 1u); }
        __syncthreads();
        myrank = (int)xb.st[2];
    }
    for (int ph = p.ph_lo; ph < p.ph_hi; ++ph) {
        if (ph > p.ph_lo) {
            const int sb = (ph - 2) & 7;
            if (ph >= 2 && xlocal && sb >= 4) xcd_local_barrier(xb, gridDim.x / 8); else xcd_barrier(xb);
        }
        if (ph == 1 && fused) {
            unsigned cc[16];
#pragma unroll
            for (int i = 0; i < 16; ++i) cc[i] = xb_ld(&bar[XB_XCNT(i)]);
            unsigned bad = gridDim.x & 7u;
#pragma unroll
            for (int i = 0; i < 16; ++i) bad |= cc[i] ^ (i < 8 ? gridDim.x / 8 : 0u);
            if (bad == 0u) { vc = myrank * 8 + (int)xb.x; xlocal = gridDim.x == 256; }
        }
        if (ph == 0) { pro_a_phase(p, lds); continue; }
        if (ph == 1) { row_phase<false>(p.x, zb, nullptr, nullptr, nullptr, mod, 1 * DM, 0, (bf16_t*)(p.ws + WS_U), nullptr, -1); continue; }
        const int l = (ph - 2) >> 3, s = (ph - 2) & 7;
        const float* modl = mod + (size_t)l * 4 * 6 * DM;
        float* stats = (float*)(p.ws + WS_STATS);
        const int rown = gridDim.x == 256 ? (vc & 7) * 2048 + (vc >> 3) * 64 : -1;
        pg8::StaticOrder S;
        if (s == 0) {
            pg8::Gemm g{(const bf16_t*)(p.ws + WS_U), (const bf16_t*)(p.ws + WS_WT_IN) + (size_t)l * DIN * LDU, T_TOK, DIN, DM, LDU, LDU};
            S.init(g.M, g.N, gridDim.x, vc);
            pg8::EpiProj E{(bf16_t*)(p.ws + WS_PROJ), (const float*)(p.ws + WS_COS), (const float*)(p.ws + WS_SIN)};
            pg8::gemm_phase<pg8::EpiProj>(lds, g, S, E);
        } else if (s == 1) {
            attn_phase(p, lds, l, 0); conv_phase(p, l);
        } else if (s == 2) {
            attn_phase(p, lds, l, 1);
        } else if (s == 3 || s == 6) {
            pg8::Gemm g; pg8::EpiRes E;
            if (s == 3) { g = pg8::Gemm{(const bf16_t*)(p.ws + WS_U), (const bf16_t*)(p.ws + WS_WT_OUT) + (size_t)l * DM * LDU, T_TOK, DM, DM, LDU, LDU};
                          E = pg8::EpiRes{zb, modl + 2 * DM, l == 0 ? nullptr : stats, p.ln2_g + (size_t)(l - (l > 0)) * DM, p.ln2_b + (size_t)(l - (l > 0)) * DM}; }
            else        { g = pg8::Gemm{(const bf16_t*)(p.ws + WS_H), (const bf16_t*)(p.ws + WS_WT_FF2) + (size_t)l * DM * LDH, T_TOK, DM, DFF, LDH, LDH};
                          E = pg8::EpiRes{zb, modl + 5 * DM, stats, p.ln1_g + (size_t)l * DM, p.ln1_b + (size_t)l * DM}; }
            S.init(g.M, g.N, gridDim.x, vc);
            pg8::gemm_phase<pg8::EpiRes>(lds, g, S, E);
        } else if (s == 4 || s == 7) {
            if (s == 4) row_phase<true>(nullptr, zb, p.out, p.ln1_g + (size_t)l * DM, p.ln1_b + (size_t)l * DM, modl, 4 * DM, 3 * DM, (bf16_t*)(p.ws + WS_U), stats, rown);
            else        row_phase<true>(nullptr, zb, p.out, p.ln2_g + (size_t)l * DM, p.ln2_b + (size_t)l * DM, modl + (size_t)4 * 6 * DM, 1 * DM, 0, (l + 1 < NLAYER) ? (bf16_t*)(p.ws + WS_U) : nullptr, (l + 1 < NLAYER) ? stats : nullptr, rown);
        } else {
            pg8::Gemm g{(const bf16_t*)(p.ws + WS_U), (const bf16_t*)(p.ws + WS_WT_FF1) + (size_t)l * DFF * LDU, T_TOK, DFF, DM, LDU, LDU};
            S.init(g.M, g.N, gridDim.x, vc);
            pg8::EpiFF1 E{(bf16_t*)(p.ws + WS_H)};
            pg8::gemm_phase<pg8::EpiFF1>(lds, g, S, E);
        }
    }
}

constexpr int N_PHASES = 2 + 8 * NLAYER;

extern "C" void kernel_launch(void* const* d_in, const int* in_sizes, int n_in, void* d_out, int out_size, void* d_ws, size_t ws_size, hipStream_t stream) {
    static int grid = 0;
    if (grid == 0) {
        int dev = 0, cus = 0, per_cu = 0;
        (void)hipGetDevice(&dev);
        (void)hipDeviceGetAttribute(&cus, hipDeviceAttributeMultiprocessorCount, dev);
        if (hipFuncSetAttribute((const void*)fwd_megakernel, hipFuncAttributeMaxDynamicSharedMemorySize, LDS_BYTES) != hipSuccess) fprintf(stderr, "hipFuncSetAttribute failed\n");
        if (hipOccupancyMaxActiveBlocksPerMultiprocessor(&per_cu, (const void*)fwd_megakernel, 512, LDS_BYTES) != hipSuccess || per_cu < 1) per_cu = 1;
        (void)hipGetLastError();
        grid = cus * per_cu;
        if (ws_size < WS_END) fprintf(stderr, "workspace too small: %zu < %zu\n", ws_size, (size_t)WS_END);
    }
    Params p{};
    p.x = (const float*)d_in[0]; p.c = (const float*)d_in[1]; p.w_in = (const float*)d_in[2]; p.conv_w = (const float*)d_in[3]; p.mix_g = (const float*)d_in[4];
    p.w_out = (const float*)d_in[5]; p.w_mod = (const float*)d_in[6]; p.b_mod = (const float*)d_in[7]; p.ln1_g = (const float*)d_in[8]; p.ln1_b = (const float*)d_in[9];
    p.w_ff1 = (const float*)d_in[10]; p.w_ff2 = (const float*)d_in[11]; p.ln2_g = (const float*)d_in[12]; p.ln2_b = (const float*)d_in[13];
    p.out = (float*)d_out; p.ws = (unsigned char*)d_ws;
#if SINGLE_LAUNCH
    (void)hipMemsetAsync((unsigned char*)d_ws + WS_CTL, 0, 20480, stream);
    p.ph_lo = 0; p.ph_hi = N_PHASES;
    void* args[] = {&p};
    hipError_t e = hipLaunchCooperativeKernel((const void*)fwd_megakernel, dim3(grid), dim3(512), args, LDS_BYTES, stream);
    if (e != hipSuccess) fprintf(stderr, "cooperative launch failed: %s (grid %d)\n", hipGetErrorString(e), grid);
#else
    for (int ph = 0; ph < N_PHASES; ++ph) {
        p.ph_lo = ph; p.ph_hi = ph + 1;
        hipLaunchKernelGGL(fwd_megakernel, dim3(grid), dim3(512), LDS_BYTES, stream, p);
    }
#endif
}
```

```cpp
#include <hip/hip_runtime.h>
#include <hip/hip_cooperative_groups.h>
#include <cstdio>
namespace cg = cooperative_groups;

#ifndef SINGLE_LAUNCH
#define SINGLE_LAUNCH 1
#endif

#define LAS __attribute__((address_space(3)))
typedef unsigned short bf16_t;
typedef short bf16x8 __attribute__((ext_vector_type(8)));
typedef short s16x4 __attribute__((ext_vector_type(4)));
typedef float f32x4 __attribute__((ext_vector_type(4)));
typedef float f32x2 __attribute__((ext_vector_type(2)));
typedef unsigned u32x4 __attribute__((ext_vector_type(4)));
typedef unsigned u32x2 __attribute__((ext_vector_type(2)));

constexpr int T_TOK = 16384, SEQ = 4096, DM = 2048, DIN = 6144, DFF = 8192, NLAYER = 2;
constexpr int KPAD = 0, LDU = DM + KPAD, LDH = DFF + KPAD;
constexpr float ALPHA = 1.4142135623730951f;
constexpr float QSCALE = 0.08838834764831845f * 1.4426950408889634f;

constexpr size_t WS_WT_IN = 0;
constexpr size_t WS_WT_OUT = WS_WT_IN + (size_t)NLAYER * DIN * LDU * 2;
constexpr size_t WS_WT_FF1 = WS_WT_OUT + (size_t)NLAYER * DM * LDU * 2;
constexpr size_t WS_WT_FF2 = WS_WT_FF1 + (size_t)NLAYER * DFF * LDU * 2;
constexpr size_t WS_MOD = WS_WT_FF2 + (size_t)NLAYER * DM * LDH * 2;
constexpr size_t WS_COS = WS_MOD + (size_t)NLAYER * 4 * 6 * DM * 4;
constexpr size_t WS_SIN = WS_COS + (size_t)SEQ * 64 * 4;
constexpr size_t WS_U = WS_SIN + (size_t)SEQ * 64 * 4;
constexpr size_t WS_PROJ = WS_U + (size_t)T_TOK * LDU * 2;
constexpr size_t WS_OPART = WS_PROJ + (size_t)T_TOK * DIN * 2;
constexpr size_t WS_LSE = WS_OPART + (size_t)3 * T_TOK * 1024 * 4;
constexpr size_t WS_CTL = WS_LSE + (size_t)3 * T_TOK * 8 * 4;
constexpr size_t WS_STATS = WS_CTL + 20480;
constexpr size_t WS_END = WS_STATS + (size_t)T_TOK * 2 * 4;
constexpr size_t WS_ZB = WS_OPART + (size_t)2 * T_TOK * 1024 * 2;
constexpr size_t WS_H = WS_PROJ;

constexpr int LDS_ST = 256 * 272 + 256 * 288;
constexpr int LDS_BYTES = LDS_ST + 16;

struct Params {
    const float* x; const float* c; const float* w_in; const float* conv_w; const float* mix_g; const float* w_out;
    const float* w_mod; const float* b_mod; const float* ln1_g; const float* ln1_b; const float* w_ff1; const float* w_ff2;
    const float* ln2_g; const float* ln2_b;
    float* out; unsigned char* ws;
    int ph_lo, ph_hi, never, pad;
};

__device__ __forceinline__ unsigned cvt_pk_bf16(float lo, float hi) { unsigned r; asm volatile("v_cvt_pk_bf16_f32 %0, %1, %2" : "=v"(r) : "v"(lo), "v"(hi)); return r; }
__device__ __forceinline__ int opaque_tid() { int t = threadIdx.x; asm volatile("" : "+v"(t)); return t; }
__device__ __forceinline__ float bf2f(unsigned short b) { return __uint_as_float(((unsigned)b) << 16); }
__device__ __forceinline__ float bflo(unsigned w) { return __uint_as_float(w << 16); }
__device__ __forceinline__ float bfhi(unsigned w) { return __uint_as_float(w & 0xffff0000u); }

namespace pg8 {
constexpr int BM = 256, BK = 64, HALF = 128, HTB = HALF * BK * 2, STAGE_BYTES = 8 * HTB, NXCD = 8, WGM = 8;
__device__ __forceinline__ int lds_byte(int r, int c) { const int st = (r >> 4) * 2 + (c >> 5), rr = r & 15, cc = c & 31, ob = rr * 64 + cc * 2; return st * 1024 + (ob ^ (((ob >> 9) & 1) << 5)); }
__device__ __forceinline__ void stage_rc(int b, int& R, int& C) { const int st = b / 1024, sb = b % 1024, swz = sb ^ (((sb >> 9) & 1) << 5); R = (st >> 1) * 16 + swz / 64; C = (st & 1) * 32 + (swz % 64) / 2; }
__device__ __forceinline__ int perm32(int rho) { const int n = rho >> 4, i = rho & 15; return 8 * (i >> 2) + 4 * n + (i & 3); }
__device__ __forceinline__ int bperm(int mode, int R) {
    if (mode == 1) return (R & ~31) + perm32(R & 31);
    if (mode == 2) return 64 * ((R >> 4) & 1) + 16 * (R >> 5) + (R & 15);
    return R;
}
__device__ __forceinline__ int bperm_inv(int mode, int s) {
    if (mode == 1) { const int t = s & 31; return (s & ~31) + 16 * ((t >> 2) & 1) + 4 * (t >> 3) + (t & 3); }
    if (mode == 2) return 32 * ((s >> 4) & 3) + 16 * (s >> 6) + (s & 15);
    return s;
}
__device__ __forceinline__ size_t tiled_off(int row, int k, int nkt) {
    return ((size_t)((row >> 7) * nkt + (k >> 6)) << 13) + (size_t)(lds_byte(row & 127, k & 63) >> 1);
}
struct Unit { int pm, pn; };
struct Gemm { const bf16_t* A; const bf16_t* Bt; int M, N, K, lda, ldb; };
struct StaticOrder {
    int nM, nN, nwg, G, c, wgm;
    __device__ void init(int M, int N, int G_, int c_, int wgm_ = WGM) { nM = M / BM; nN = N / BM; nwg = nM * nN; G = G_; c = c_; wgm = wgm_; }
    __device__ bool next(int i, Unit& u) const {
        const long L = (long)i * G + c; if (L >= nwg) return false;
        int wgid = (int)L; { const int q = nwg / NXCD, r = nwg % NXCD, xcd = wgid % NXCD, off = wgid / NXCD; wgid = (xcd < r ? xcd * (q + 1) : r * (q + 1) + (xcd - r) * q) + off; }
        const int nig = wgm * nN, gid = wgid / nig, fm = gid * wgm, gsz = (nM - fm) < wgm ? (nM - fm) : wgm;
        u.pm = fm + ((wgid % nig) % gsz); u.pn = (wgid % nig) / gsz; return true;
    }
};

template <class Epi>
__device__ __forceinline__ void gemm_phase(LAS unsigned char* lds, const Gemm g, const StaticOrder& S, const Epi& E) {
    const int tid = opaque_tid(), wid = __builtin_amdgcn_readfirstlane(tid >> 6), lane = tid & 63, wr = wid >> 2, wc = wid & 3, fr = lane & 15, fq = lane >> 4;
    const int K = g.K, nt = K / BK;
    unsigned voffA[2], voffB[2];
#pragma unroll
    for (int i = 0; i < 2; ++i) { voffA[i] = (unsigned)(tid * 16 + i * 8192); voffB[i] = voffA[i]; }
    const size_t kstep = (size_t)HTB;
    const size_t hstepA = (size_t)nt * HTB, hstepB = hstepA;
    const size_t tstepA = 2 * hstepA, tstepB = tstepA;
    const unsigned ldsw = (unsigned)wid * 1024u;
    const int aoff = lds_byte(wr * 64 + fr, fq * 8), boff = lds_byte(wc * 32 + fr, fq * 8);
#define PG8_SA(b, h) (((b) * 2 + (h)) * HTB)
#define PG8_SB(b, h) ((4 + (b) * 2 + (h)) * HTB)
#define PG8_STAGE(bufoff, gbase, voff) do { _Pragma("unroll") for (int _i = 0; _i < 2; ++_i) \
        __builtin_amdgcn_global_load_lds((const unsigned*)((const char*)(gbase) + (voff)[_i]), (LAS unsigned*)(lds + (bufoff) + ldsw + _i * 8192), 16, 0, 0); } while (0)
#define PG8_LDA(dst, b, h) do { _Pragma("unroll") for (int m = 0; m < 4; ++m) _Pragma("unroll") for (int k = 0; k < 2; ++k) dst[m][k] = *(const LAS bf16x8*)(lds + PG8_SA(b, h) + aoff + m * 2048 + k * 1024); } while (0)
#define PG8_LDB(dst, b, h) do { _Pragma("unroll") for (int n = 0; n < 2; ++n) _Pragma("unroll") for (int k = 0; k < 2; ++k) dst[n][k] = *(const LAS bf16x8*)(lds + PG8_SB(b, h) + boff + n * 2048 + k * 1024); } while (0)
#define PG8_MMA(ai, bj, At, Bt) do { __builtin_amdgcn_s_setprio(1); _Pragma("unroll") for (int m = 0; m < 4; ++m) _Pragma("unroll") for (int n = 0; n < 2; ++n) _Pragma("unroll") for (int k = 0; k < 2; ++k) \
        acc[ai][bj][m][n] = __builtin_amdgcn_mfma_f32_16x16x32_bf16(Bt[n][k], At[m][k], acc[ai][bj][m][n], 0, 0, 0); __builtin_amdgcn_s_setprio(0); } while (0)
#define PG8_WAIT_V(n) asm volatile("s_waitcnt vmcnt(" #n ")" ::: "memory")
#define PG8_WAIT_L(n) asm volatile("s_waitcnt lgkmcnt(" #n ")" ::: "memory")
#define PG8_BAR __builtin_amdgcn_s_barrier()
#define PG8_SCHED __builtin_amdgcn_sched_barrier(0)
    Unit cur, nxt; int ui = 0;
    if (!S.next(0, cur)) return;
    f32x4 acc[2][2][4][2];
#pragma unroll
    for (int a = 0; a < 2; ++a)
#pragma unroll
        for (int b = 0; b < 2; ++b)
#pragma unroll
            for (int m = 0; m < 4; ++m)
#pragma unroll
                for (int n = 0; n < 2; ++n) acc[a][b][m][n] = (f32x4){0.f, 0.f, 0.f, 0.f};
    bf16x8 At[4][2], B0[2][2], B1[2][2];
    const char* cA = (const char*)g.A + (size_t)cur.pm * tstepA; const char* cB = (const char*)g.Bt + (size_t)cur.pn * tstepB;
    PG8_STAGE(PG8_SB(0, 0), cB, voffB); PG8_STAGE(PG8_SA(0, 0), cA, voffA); PG8_STAGE(PG8_SB(0, 1), cB + hstepB, voffB); PG8_STAGE(PG8_SA(0, 1), cA + hstepA, voffA);
    if (wr == 1) PG8_BAR;
    PG8_WAIT_V(4); PG8_BAR;
    PG8_STAGE(PG8_SB(1, 0), cB + kstep, voffB); PG8_STAGE(PG8_SA(1, 0), cA + kstep, voffA); PG8_STAGE(PG8_SB(1, 1), cB + hstepB + kstep, voffB);
    PG8_WAIT_V(6); PG8_BAR;
    for (;;) {
        const bool has_next = S.next(ui + 1, nxt);
        const char* nA = has_next ? (const char*)g.A + (size_t)nxt.pm * tstepA : cA; const char* nB = has_next ? (const char*)g.Bt + (size_t)nxt.pn * tstepB : cB;
        for (int t = 0; t < nt; t += 2) {
            const bool last = (t == nt - 2);
            const char* a1 = cA + (size_t)(t + 1) * kstep;
            const char* a2 = last ? nA : cA + (size_t)(t + 2) * kstep; const char* b2 = last ? nB : cB + (size_t)(t + 2) * kstep;
            const char* a3 = a2 + kstep; const char* b3 = b2 + kstep;
            PG8_LDB(B0, 0, 0); PG8_SCHED; PG8_LDA(At, 0, 0); PG8_STAGE(PG8_SA(1, 1), a1 + hstepA, voffA);
            PG8_WAIT_L(8); PG8_BAR; PG8_WAIT_L(0); PG8_MMA(0, 0, At, B0); PG8_BAR; PG8_SCHED;
            PG8_LDB(B1, 0, 1); PG8_STAGE(PG8_SB(0, 0), b2, voffB);
            PG8_BAR; PG8_WAIT_L(0); PG8_MMA(0, 1, At, B1); PG8_BAR;
            PG8_LDA(At, 0, 1); PG8_STAGE(PG8_SA(0, 0), a2, voffA);
            PG8_BAR; PG8_WAIT_L(0); PG8_MMA(1, 0, At, B0); PG8_BAR; PG8_SCHED;
            PG8_STAGE(PG8_SB(0, 1), b2 + hstepB, voffB);
            PG8_WAIT_V(6); PG8_BAR; PG8_MMA(1, 1, At, B1); PG8_BAR;
            PG8_LDB(B0, 1, 0); PG8_SCHED; PG8_LDA(At, 1, 0); PG8_STAGE(PG8_SA(0, 1), a2 + hstepA, voffA);
            PG8_WAIT_L(8); PG8_BAR; PG8_WAIT_L(0); PG8_MMA(0, 0, At, B0); PG8_BAR; PG8_SCHED;
            PG8_LDB(B1, 1, 1); PG8_STAGE(PG8_SB(1, 0), b3, voffB);
            PG8_BAR; PG8_WAIT_L(0); PG8_MMA(0, 1, At, B1); PG8_BAR;
            PG8_LDA(At, 1, 1); PG8_STAGE(PG8_SA(1, 0), a3, voffA);
            PG8_BAR; PG8_WAIT_L(0); PG8_MMA(1, 0, At, B0); PG8_BAR; PG8_SCHED;
            PG8_STAGE(PG8_SB(1, 1), b3 + hstepB, voffB);
            PG8_WAIT_V(6); PG8_BAR; PG8_MMA(1, 1, At, B1); PG8_BAR;
        }
        E(acc, cur, wr, wc, fr, fq);
        if (!has_next) break;
#pragma unroll
        for (int a = 0; a < 2; ++a)
#pragma unroll
            for (int b = 0; b < 2; ++b)
#pragma unroll
                for (int m = 0; m < 4; ++m)
#pragma unroll
                    for (int n = 0; n < 2; ++n) acc[a][b][m][n] = (f32x4){0.f, 0.f, 0.f, 0.f};
        cur = nxt; cA = nA; cB = nB; ++ui;
    }
    PG8_WAIT_V(0);
    if (wr == 0) PG8_BAR;
    PG8_BAR;
#undef PG8_SA
#undef PG8_SB
#undef PG8_STAGE
#undef PG8_LDA
#undef PG8_LDB
#undef PG8_MMA
#undef PG8_WAIT_V
#undef PG8_WAIT_L
#undef PG8_BAR
#undef PG8_SCHED
}

struct EpiProj {
    static constexpr int PERM = 2;
    bf16_t* O; const float* cosT; const float* sinT;
    __device__ __forceinline__ void operator()(const f32x4 (&acc)[2][2][4][2], const Unit& u, int wr, int wc, int fr, int fq) const {
        const int row0 = u.pm * BM + wr * 64 + fr, j0 = wc * 16 + 4 * fq, colb = u.pn * BM + j0;
        if (u.pn < 8) {
            const float sc = (u.pn < 4) ? QSCALE : 1.0f;
#pragma unroll
            for (int ai = 0; ai < 2; ++ai) {
                f32x4 csv[4], snv[4];
#pragma unroll
                for (int m = 0; m < 4; ++m) { const int pos = (row0 + ai * HALF + m * 16) & (SEQ - 1); csv[m] = *(const f32x4*)(cosT + pos * 64 + j0); snv[m] = *(const f32x4*)(sinT + pos * 64 + j0); }
#pragma unroll
                for (int m = 0; m < 4; ++m) {
                    const int row = row0 + ai * HALF + m * 16;
                    const f32x4 cs = csv[m], sn = snv[m];
                    bf16_t* rowp = O + (size_t)row * DIN + colb;
#pragma unroll
                    for (int bj = 0; bj < 2; ++bj) {
                        const f32x4 a = acc[ai][bj][m][0], b = acc[ai][bj][m][1];
                        const f32x4 o1 = (a * cs - b * sn) * sc, o2 = (b * cs + a * sn) * sc;
                        u32x2 w1, w2; w1.x = cvt_pk_bf16(o1[0], o1[1]); w1.y = cvt_pk_bf16(o1[2], o1[3]); w2.x = cvt_pk_bf16(o2[0], o2[1]); w2.y = cvt_pk_bf16(o2[2], o2[3]);
                        *(u32x2*)(rowp + bj * HALF) = w1; *(u32x2*)(rowp + bj * HALF + 64) = w2;
                    }
                }
            }
        } else {
#pragma unroll
            for (int ai = 0; ai < 2; ++ai)
#pragma unroll
                for (int m = 0; m < 4; ++m) {
                    const int row = row0 + ai * HALF + m * 16;
                    bf16_t* rowp = O + (size_t)row * DIN + colb;
#pragma unroll
                    for (int bj = 0; bj < 2; ++bj) {
                        const f32x4 o1 = acc[ai][bj][m][0], o2 = acc[ai][bj][m][1];
                        u32x2 w1, w2; w1.x = cvt_pk_bf16(o1[0], o1[1]); w1.y = cvt_pk_bf16(o1[2], o1[3]); w2.x = cvt_pk_bf16(o2[0], o2[1]); w2.y = cvt_pk_bf16(o2[2], o2[3]);
                        *(u32x2*)(rowp + bj * HALF) = w1; *(u32x2*)(rowp + bj * HALF + 64) = w2;
                    }
                }
        }
    }
};
struct EpiRes {
    static constexpr int PERM = 1;
    bf16_t* z; const float* gate;
    const float* stats; const float* lng; const float* lnb;
    __device__ __forceinline__ void operator()(const f32x4 (&acc)[2][2][4][2], const Unit& u, int wr, int wc, int fr, int fq) const {
        const int row0 = u.pm * BM + wr * 64 + fr, col0 = u.pn * BM + wc * 32 + 8 * fq;
        const float* gb = gate + (size_t)(row0 >> 12) * (6 * DM);
        const bool ln = stats != nullptr;
        constexpr int GB[4] = {0, 4, 8, 16};
        f32x2 st[4];
#pragma unroll
        for (int grp = 0; grp < 3; ++grp) {
            u32x4 xv[8]; f32x4 cg[2][2], cl[2][2], cb[2][2];
            if (grp == 0 || grp == 2) {
#pragma unroll
                for (int m = 0; m < 4; ++m) st[m] = ln ? *(const f32x2*)(stats + 2 * (row0 + (grp ? HALF : 0) + m * 16)) : (f32x2){0.f, 1.f};
            }
#pragma unroll
            for (int j = GB[grp]; j < GB[grp + 1]; ++j) {
                const int k = j >> 2, m = j & 3, ai = k >> 1, col = col0 + (k & 1) * HALF, kk = k - (GB[grp] >> 2);
                if (m == 0) {
#pragma unroll
                    for (int n = 0; n < 2; ++n) { cg[kk][n] = *(const f32x4*)(gb + col + 4 * n) + 1.0f; cl[kk][n] = (f32x4){1.f, 1.f, 1.f, 1.f}; cb[kk][n] = (f32x4){0.f, 0.f, 0.f, 0.f};
                        if (ln) { cl[kk][n] = *(const f32x4*)(lng + col + 4 * n); cb[kk][n] = *(const f32x4*)(lnb + col + 4 * n); } }
                }
                xv[j - GB[grp]] = *(const u32x4*)(z + (size_t)(row0 + ai * HALF + m * 16) * DM + col);
            }
#pragma unroll
            for (int j = GB[grp]; j < GB[grp + 1]; ++j) {
                const int k = j >> 2, m = j & 3, ai = k >> 1, bj = k & 1, col = col0 + bj * HALF, kk = k - (GB[grp] >> 2);
                const u32x4 r = xv[j - GB[grp]];
                f32x4 x0 = {bflo(r.x), bfhi(r.x), bflo(r.y), bfhi(r.y)}, x1 = {bflo(r.z), bfhi(r.z), bflo(r.w), bfhi(r.w)};
                x0 = (x0 - st[m].x) * st[m].y * cl[kk][0] + cb[kk][0]; x1 = (x1 - st[m].x) * st[m].y * cl[kk][1] + cb[kk][1];
                const f32x4 o0 = x0 * ALPHA + cg[kk][0] * acc[ai][bj][m][0], o1 = x1 * ALPHA + cg[kk][1] * acc[ai][bj][m][1];
                u32x4 w; w.x = cvt_pk_bf16(o0[0], o0[1]); w.y = cvt_pk_bf16(o0[2], o0[3]); w.z = cvt_pk_bf16(o1[0], o1[1]); w.w = cvt_pk_bf16(o1[2], o1[3]);
                *(u32x4*)(z + (size_t)(row0 + ai * HALF + m * 16) * DM + col) = w;
            }
        }
    }
};
struct EpiFF1 {
    static constexpr int PERM = 1;
    bf16_t* O;
    __device__ __forceinline__ void operator()(const f32x4 (&acc)[2][2][4][2], const Unit& u, int wr, int wc, int fr, int fq) const {
        const int row0 = u.pm * BM + wr * 64 + fr, col0 = u.pn * BM + wc * 32 + 8 * fq;
#pragma unroll
        for (int ai = 0; ai < 2; ++ai)
#pragma unroll
            for (int m = 0; m < 4; ++m) {
                const int rowi = row0 + ai * HALF + m * 16;
#pragma unroll
                for (int bj = 0; bj < 2; ++bj) {
                    f32x4 v0 = acc[ai][bj][m][0], v1 = acc[ai][bj][m][1];
#pragma unroll
                    for (int j = 0; j < 4; ++j) { const float a = fmaxf(v0[j], 0.f), b = fmaxf(v1[j], 0.f); v0[j] = a * a; v1[j] = b * b; }
                    u32x4 w; w.x = cvt_pk_bf16(v0[0], v0[1]); w.y = cvt_pk_bf16(v0[2], v0[3]); w.z = cvt_pk_bf16(v1[0], v1[1]); w.w = cvt_pk_bf16(v1[2], v1[3]);
                    *(u32x4*)(O + tiled_off(rowi, col0 + bj * HALF, DFF / 64)) = w;
                }
            }
    }
};
}

__device__ __forceinline__ void pro_a_phase(const Params& p, LAS unsigned char* lds) {
    const int tid = opaque_tid();
    LAS float* cond = (LAS float*)lds;
    LAS float* red = (LAS float*)(lds + 32768);
    LAS float* tile = (LAS float*)(lds + 65536);
    float* mod = (float*)(p.ws + WS_MOD);
    const int G = gridDim.x;
    constexpr int N_GEMV = 256, N_ROPE = 512, N_TR = 12288, FIRST_TR = N_GEMV + N_ROPE;
    if ((int)blockIdx.x < N_GEMV) {
        for (int i = tid; i < 4 * DM; i += 512) { const float v = p.c[i]; cond[i] = v / (1.0f + __expf(-v)); }
        __syncthreads();
    }
    int item = blockIdx.x;
    for (; item < FIRST_TR; item += G) {
        if (item < N_GEMV) {
            const int l = item >> 7, n0 = (item & 127) * 96, cq = tid & 31, kg = tid >> 5;
            const float* wp = p.w_mod + (size_t)l * DM * (6 * DM) + (size_t)(kg * 128) * (6 * DM) + n0 + cq * 4;
            const LAS float* cp = cond + kg * 128;
            f32x4 a0 = {0.f, 0.f, 0.f, 0.f}, a1 = a0, a2 = a0, a3 = a0;
            if (cq < 24)
#pragma unroll 8
            for (int k = 0; k < 128; ++k) {
                const f32x4 w = __builtin_nontemporal_load((const f32x4*)(wp + (size_t)k * (6 * DM)));
                a0 += w * cp[k]; a1 += w * cp[DM + k]; a2 += w * cp[2 * DM + k]; a3 += w * cp[3 * DM + k];
            }
            *(LAS f32x4*)(red + (kg * 4 + 0) * 128 + cq * 4) = a0; *(LAS f32x4*)(red + (kg * 4 + 1) * 128 + cq * 4) = a1;
            *(LAS f32x4*)(red + (kg * 4 + 2) * 128 + cq * 4) = a2; *(LAS f32x4*)(red + (kg * 4 + 3) * 128 + cq * 4) = a3;
            __syncthreads();
            { const int b = tid >> 7, col = tid & 127;
              if (col < 96) { float s = p.b_mod[l * 6 * DM + n0 + col];
#pragma unroll
                for (int k2 = 0; k2 < 16; ++k2) s += red[(k2 * 4 + b) * 128 + col];
                mod[((size_t)l * 4 + b) * (6 * DM) + n0 + col] = s; } }
            __syncthreads();
        } else {
            const int idx = (item - N_GEMV) * 512 + tid, pos = idx >> 6, j = idx & 63;
            double invd = 1.0;
#pragma nounroll
            for (int k = 0; k < j; ++k) invd *= 0.86596432336006535;
            const float inv = (float)invd;
            const float ang = (float)pos * inv;
            const double xd = (double)ang, kk = rint(xd * 0.15915494309189535), y = xd - kk * 6.283185307179586, y2 = y * y;
            double s = 1.0, c = 1.0;
#pragma nounroll
            for (int k = 13; k >= 1; --k) { s = 1.0 - s * y2 / (double)((2 * k) * (2 * k + 1)); c = 1.0 - c * y2 / (double)((2 * k - 1) * (2 * k)); }
            ((float*)(p.ws + WS_COS))[idx] = (float)c; ((float*)(p.ws + WS_SIN))[idx] = (float)(y * s);
        }
    }
    auto decode = [&](int tt, const float*& src, bf16_t*& dst, int& K, int& N, int& mode, int& n0, int& k0) {
        const int l = tt / 6144, u = tt % 6144; int v;
        if (u < 1536) { mode = 2; K = DM; N = DIN; v = u; src = p.w_in + (size_t)l * DM * DIN; dst = (bf16_t*)(p.ws + WS_WT_IN) + (size_t)l * DIN * LDU; }
        else if (u < 2048) { mode = 1; K = DM; N = DM; v = u - 1536; src = p.w_out + (size_t)l * DM * DM; dst = (bf16_t*)(p.ws + WS_WT_OUT) + (size_t)l * DM * LDU; }
        else if (u < 4096) { mode = 1; K = DM; N = DFF; v = u - 2048; src = p.w_ff1 + (size_t)l * DM * DFF; dst = (bf16_t*)(p.ws + WS_WT_FF1) + (size_t)l * DFF * LDU; }
        else { mode = 1; K = DFF; N = DM; v = u - 4096; src = p.w_ff2 + (size_t)l * DFF * DM; dst = (bf16_t*)(p.ws + WS_WT_FF2) + (size_t)l * DM * LDH; }
        const int ntn = N >> 6, kt = v / ntn, nt = v % ntn;
        src += (size_t)(kt * 128) * N + nt * 64; n0 = nt * 64; k0 = kt * 128;
    };
    const int lk = tid >> 4, ln4 = tid & 15;
    const int sn = tid >> 4, skc = tid & 15;
    int tt = item - FIRST_TR;
    if (tt < N_TR) {
        const float* src; bf16_t* dst; int K, N, mode, n0, k0; decode(tt, src, dst, K, N, mode, n0, k0);
        f32x4 rg[4];
#pragma unroll
        for (int i = 0; i < 4; ++i) rg[i] = __builtin_nontemporal_load((const f32x4*)(src + (size_t)(lk + 32 * i) * N + ln4 * 4));
        for (;;) {
#pragma unroll
            for (int i = 0; i < 4; ++i) { LAS float* tp = tile + (lk + 32 * i) * 65 + ln4 * 4; tp[0] = rg[i][0]; tp[1] = rg[i][1]; tp[2] = rg[i][2]; tp[3] = rg[i][3]; }
            asm volatile("s_waitcnt lgkmcnt(0)" ::: "memory"); __builtin_amdgcn_s_barrier(); asm volatile("" ::: "memory");
            bf16_t* cdst = dst; const int cnkt = K >> 6, cmode = mode, cn0 = n0, ck0 = k0;
            const int tn = tt + G;
            if (tn < N_TR) { decode(tn, src, dst, K, N, mode, n0, k0);
#pragma unroll
                for (int i = 0; i < 4; ++i) rg[i] = __builtin_nontemporal_load((const f32x4*)(src + (size_t)(lk + 32 * i) * N + ln4 * 4)); }
#pragma unroll
            for (int i = 0; i < 2; ++i) {
                const int n = sn + 32 * i; const LAS float* tp = tile + (skc * 8) * 65 + n;
                u32x4 w; w.x = cvt_pk_bf16(tp[0], tp[65]); w.y = cvt_pk_bf16(tp[130], tp[195]); w.z = cvt_pk_bf16(tp[260], tp[325]); w.w = cvt_pk_bf16(tp[390], tp[455]);
                const int ng = cn0 + n, np = (ng & ~127) + pg8::bperm_inv(cmode, ng & 127);
                *(u32x4*)(cdst + pg8::tiled_off(np, ck0 + skc * 8, cnkt)) = w;
            }
            asm volatile("s_waitcnt lgkmcnt(0)" ::: "memory"); __builtin_amdgcn_s_barrier(); asm volatile("" ::: "memory");
            if (tn >= N_TR) break;
            tt = tn;
        }
    }
}

template <bool DO_LN>
__device__ __forceinline__ void row_phase(const float* xin, bf16_t* zb, float* xout, const float* g, const float* bta, const float* modl, int sc_off, int sh_off, bf16_t* U, float* stats, int rbase) {
    const int tid = opaque_tid(), wid = tid >> 6, lane = tid & 63;
    const int rstep = rbase >= 0 ? 8 : (int)gridDim.x * 8, rend = rbase >= 0 ? rbase + 64 : T_TOK;
    f32x4 vn[8]; u32x2 vb[8];
    int row = (rbase >= 0 ? rbase : (int)blockIdx.x * 8) + wid;
    if (row < rend) {
#pragma unroll
        for (int i = 0; i < 8; ++i) { if (DO_LN) vb[i] = *(const u32x2*)(zb + (size_t)row * DM + lane * 4 + i * 256); else vn[i] = __builtin_nontemporal_load((const f32x4*)(xin + (size_t)row * DM + lane * 4 + i * 256)); }
    }
    for (; row < rend; row += rstep) {
        f32x4 v[8], scv[8], shv[8];
#pragma unroll
        for (int i = 0; i < 8; ++i) { if (DO_LN) v[i] = (f32x4){bflo(vb[i].x), bfhi(vb[i].x), bflo(vb[i].y), bfhi(vb[i].y)}; else v[i] = vn[i]; }
        { const int nrow = row + rstep;
          if (nrow < rend) {
#pragma unroll
              for (int i = 0; i < 8; ++i) { if (DO_LN) vb[i] = *(const u32x2*)(zb + (size_t)nrow * DM + lane * 4 + i * 256); else vn[i] = __builtin_nontemporal_load((const f32x4*)(xin + (size_t)nrow * DM + lane * 4 + i * 256)); }
          } }
        if (DO_LN) {
            float s = 0.f;
#pragma unroll
            for (int i = 0; i < 8; ++i) s += (v[i][0] + v[i][1]) + (v[i][2] + v[i][3]);
#pragma unroll
            for (int o = 32; o >= 1; o >>= 1) s += __shfl_xor(s, o);
            const float mu = s * (1.0f / DM);
            float q = 0.f;
#pragma unroll
            for (int i = 0; i < 8; ++i) { v[i] -= mu; q += (v[i][0] * v[i][0] + v[i][1] * v[i][1]) + (v[i][2] * v[i][2] + v[i][3] * v[i][3]); }
#pragma unroll
            for (int o = 32; o >= 1; o >>= 1) q += __shfl_xor(q, o);
            const float rstd = rsqrtf(q * (1.0f / DM) + 1e-5f);
            const unsigned voff = (unsigned)lane * 16u;
            {
                f32x4 gg[8], bb[8];
#pragma unroll
                for (int i = 0; i < 8; ++i) { gg[i] = *(const f32x4*)((const char*)g + (voff + (unsigned)i * 1024u)); bb[i] = *(const f32x4*)((const char*)bta + (voff + (unsigned)i * 1024u)); }
#pragma unroll
                for (int i = 0; i < 8; ++i) v[i] = v[i] * rstd * gg[i] + bb[i];
            }
            if (U) {
                const char* mb = (const char*)(modl + (size_t)(row >> 12) * (6 * DM));
#pragma unroll
                for (int i = 0; i < 8; ++i) { scv[i] = *(const f32x4*)(mb + ((unsigned)sc_off * 4u + voff + (unsigned)i * 1024u)); shv[i] = *(const f32x4*)(mb + ((unsigned)sh_off * 4u + voff + (unsigned)i * 1024u)); }
            }
            if (stats) { if (lane == 0) *(f32x2*)(stats + 2 * row) = (f32x2){mu, rstd}; }
            else {
                float* op = xout + (size_t)row * DM + lane * 4;
#pragma unroll
                for (int i = 0; i < 8; ++i) __builtin_nontemporal_store(v[i], (f32x4*)(op + i * 256));
            }
        }
        if (U) {
            if (!DO_LN) {
                const unsigned voff = (unsigned)lane * 16u;
                const char* mb = (const char*)(modl + (size_t)(row >> 12) * (6 * DM));
#pragma unroll
                for (int i = 0; i < 8; ++i) { scv[i] = *(const f32x4*)(mb + ((unsigned)sc_off * 4u + voff + (unsigned)i * 1024u)); shv[i] = *(const f32x4*)(mb + ((unsigned)sh_off * 4u + voff + (unsigned)i * 1024u)); }
            }
#pragma unroll
            for (int i = 0; i < 8; ++i) {
                const f32x4 uu = v[i] * (scv[i] + 1.0f) + shv[i];
                u32x2 w; w.x = cvt_pk_bf16(uu[0], uu[1]); w.y = cvt_pk_bf16(uu[2], uu[3]);
                *(u32x2*)(U + pg8::tiled_off(row, i * 256 + lane * 4, DM / 64)) = w;
                if (!DO_LN) { u32x2 wz; wz.x = cvt_pk_bf16(v[i][0], v[i][1]); wz.y = cvt_pk_bf16(v[i][2], v[i][3]); *(u32x2*)(zb + (size_t)row * DM + lane * 4 + i * 256) = wz; }
            }
        }
    }
}

struct AttnStep { size_t tb; int h, dl, r, n, br, first; };
__device__ __forceinline__ AttnStep attn_step(int wg, int q, int mode) {
    AttnStep a;
    if (mode) { const int bh = wg >> 3; a.tb = (size_t)(bh >> 3) * SEQ; a.h = bh & 7; a.br = 0; a.dl = 0; a.r = 0; a.n = 4 * (wg & 7) + q; a.first = (q == 0); }
    else if (wg < 128) { a.tb = (size_t)(wg >> 5) * SEQ; a.h = (wg >> 2) & 7; a.br = 1; a.dl = 2; a.r = wg & 3; a.n = q; a.first = (q == 0); }
    else { const int c16 = (wg - 128) * 4 + (q >> 1); a.tb = (size_t)(c16 >> 7) * SEQ; a.h = (c16 >> 4) & 7; a.br = 2; a.dl = 4; a.r = c16 & 15; a.n = q & 1; a.first = !(q & 1); }
    return a;
}
__device__ __forceinline__ void attn_phase(const Params& p, LAS unsigned char* lds, int l, int mode) {
    const bf16_t* proj = (const bf16_t*)(p.ws + WS_PROJ);
    bf16_t* opart = (bf16_t*)(p.ws + WS_OPART); float* lse = (float*)(p.ws + WS_LSE);
    bf16_t* mixed = (bf16_t*)(p.ws + WS_U);
    const float* gain = p.mix_g + (size_t)l * DM;
    const int tid = opaque_tid(), wid = tid >> 6, lane = tid & 63, li = lane & 15, g = lane >> 4;
    LAS unsigned char* Kl = lds; LAS unsigned char* Vl = lds + 256 * 272;
    constexpr int KH = 128 * 272, VH = 128 * 288;
    const int nsteps = mode ? 4 : 8;
    u32x4 kv[4], vv[4]; bf16x8 qf[4];
#define ATTN_LOAD_BLK(A, NB) do { _Pragma("unroll") for (int i = 0; i < 4; ++i) { const int idx = tid + 512 * i, row = idx >> 4, ch = idx & 15; \
            const bf16_t* src = proj + ((A).tb + ((size_t)((NB) * 128 + row) << (A).dl) + (A).r) * DIN + (A).h * 128 + ch * 8; kv[i] = *(const u32x4*)(src + 1024); vv[i] = *(const u32x4*)(src + 2048); } } while (0)
#define ATTN_STORE_BLK(HH) do { _Pragma("unroll") for (int i = 0; i < 4; ++i) { const int idx = tid + 512 * i, row = idx >> 4, ch = idx & 15; \
            *(LAS u32x4*)(Kl + (HH) * KH + row * 272 + ch * 16) = kv[i]; *(LAS u32x4*)(Vl + (HH) * VH + row * 288 + ch * 16) = vv[i]; } } while (0)
#define ATTN_LOAD_Q(A) do { const size_t qt_ = (A).tb + ((size_t)((A).n * 128 + wid * 16 + li) << (A).dl) + (A).r; \
            _Pragma("unroll") for (int s = 0; s < 4; ++s) qf[s] = *(const bf16x8*)(proj + qt_ * DIN + (A).h * 128 + s * 32 + g * 8); } while (0)
    for (int wg = blockIdx.x; wg < 256; wg += gridDim.x) {
        AttnStep cur = attn_step(wg, 0, mode);
        if (mode && cur.n > 0) { ATTN_LOAD_BLK(cur, cur.n - 1); ATTN_STORE_BLK(1); }
        ATTN_LOAD_BLK(cur, cur.n); ATTN_LOAD_Q(cur);
        for (int q = 0; q < nsteps; ++q) {
            const int c = q & 1;
            if (cur.first && cur.n == 0) {
#pragma unroll
                for (int i = 0; i < 4; ++i) { const int idx = tid + 512 * i, row = idx >> 4, ch = idx & 15;
                    *(LAS u32x4*)(Kl + (c ^ 1) * KH + row * 272 + ch * 16) = (u32x4){0u, 0u, 0u, 0u}; *(LAS u32x4*)(Vl + (c ^ 1) * VH + row * 288 + ch * 16) = (u32x4){0u, 0u, 0u, 0u}; }
            }
            ATTN_STORE_BLK(c);
            bf16x8 qc[4];
#pragma unroll
            for (int s = 0; s < 4; ++s) qc[s] = qf[s];
            asm volatile("s_waitcnt lgkmcnt(0)" ::: "memory"); __builtin_amdgcn_s_barrier(); asm volatile("" ::: "memory");
            AttnStep nxt = attn_step(wg, (q + 1 < nsteps) ? q + 1 : q, mode);
            if (q + 1 < nsteps) { ATTN_LOAD_BLK(nxt, nxt.n); ATTN_LOAD_Q(nxt); }
            const int n = cur.n, dl = cur.dl, h = cur.h, mbase = (n - 1) * 128;
            const int qi = wid * 16 + li; const size_t qtok = cur.tb + ((size_t)(n * 128 + qi) << dl) + cur.r;
            const int kb0 = wid & ~1;
            const int koffP = (c ^ 1) * KH, koffC = c * KH, voffP = (c ^ 1) * VH, voffC = c * VH;
            f32x4 sacc[10];
#pragma unroll
            for (int i = 0; i < 10; ++i) {
                sacc[i] = (f32x4){0.f, 0.f, 0.f, 0.f};
                const int kb = kb0 + i, koff = (kb < 8) ? koffP + kb * (16 * 272) : koffC + (kb - 8) * (16 * 272);
#pragma unroll
                for (int s = 0; s < 4; ++s) {
                    const bf16x8 kf = *(const LAS bf16x8*)(Kl + koff + li * 272 + (32 * s + 8 * g) * 2);
                    sacc[i] = __builtin_amdgcn_mfma_f32_16x16x32_bf16(kf, qc[s], sacc[i], 0, 0, 0);
                }
            }
            float mx = -1e30f;
#pragma unroll
            for (int i = 0; i < 10; ++i)
#pragma unroll
                for (int j = 0; j < 4; ++j) {
                    const int kj = 16 * (kb0 + i) + 4 * g + j, dist = 128 + qi - kj;
                    const bool valid = (dist >= 0) && (dist <= 128) && (mbase + kj >= 0);
                    const float sv = valid ? sacc[i][j] : -1e30f;
                    sacc[i][j] = sv; mx = fmaxf(mx, sv);
                }
            mx = fmaxf(mx, __shfl_xor(mx, 16)); mx = fmaxf(mx, __shfl_xor(mx, 32));
            float lsum = 0.f;
#pragma unroll
            for (int i = 0; i < 10; ++i)
#pragma unroll
                for (int j = 0; j < 4; ++j) { const float pv = __builtin_amdgcn_exp2f(sacc[i][j] - mx); sacc[i][j] = pv; lsum += pv; }
            lsum += __shfl_xor(lsum, 16); lsum += __shfl_xor(lsum, 32);
            u32x2 x1[8], x2[8]; float l1 = 0.f, l2 = 0.f;
            if (mode) {
                l1 = lse[qtok * 8 + h]; l2 = lse[((size_t)T_TOK + qtok) * 8 + h];
                const bf16_t* p1 = opart + qtok * 1024 + h * 128 + 4 * g; const bf16_t* p2 = p1 + (size_t)T_TOK * 1024;
#pragma unroll
                for (int db = 0; db < 8; ++db) { x1[db] = *(const u32x2*)(p1 + 16 * db); x2[db] = *(const u32x2*)(p2 + 16 * db); }
            }
            f32x4 oacc[8];
#pragma unroll
            for (int db = 0; db < 8; ++db) oacc[db] = (f32x4){0.f, 0.f, 0.f, 0.f};
            const int vlane = (4 * g + (li >> 2)) * 288 + (4 * (li & 3)) * 2;
#pragma unroll
            for (int t = 0; t < 5; ++t) {
                u32x4 pw; pw.x = cvt_pk_bf16(sacc[2 * t][0], sacc[2 * t][1]); pw.y = cvt_pk_bf16(sacc[2 * t][2], sacc[2 * t][3]);
                pw.z = cvt_pk_bf16(sacc[2 * t + 1][0], sacc[2 * t + 1][1]); pw.w = cvt_pk_bf16(sacc[2 * t + 1][2], sacc[2 * t + 1][3]);
                const bf16x8 pf = __builtin_bit_cast(bf16x8, pw);
                const int kbv = kb0 + 2 * t, voff = (kbv < 8) ? voffP + kbv * (16 * 288) : voffC + (kbv - 8) * (16 * 288);
                const LAS unsigned char* vb = Vl + voff + vlane;
#pragma unroll
                for (int db = 0; db < 8; ++db) {
                    const s16x4 lo = __builtin_bit_cast(s16x4, __builtin_amdgcn_ds_read_tr16_b64_v4i16((LAS s16x4*)(vb + db * 32)));
                    const s16x4 hi = __builtin_bit_cast(s16x4, __builtin_amdgcn_ds_read_tr16_b64_v4i16((LAS s16x4*)(vb + 16 * 288 + db * 32)));
                    const bf16x8 vf = __builtin_shufflevector(lo, hi, 0, 1, 2, 3, 4, 5, 6, 7);
                    oacc[db] = __builtin_amdgcn_mfma_f32_16x16x32_bf16(vf, pf, oacc[db], 0, 0, 0);
                }
            }
            const float inv = 1.0f / lsum, lse0 = mx + __builtin_amdgcn_logf(lsum);
            if (mode == 0) {
                bf16_t* op = opart + ((size_t)(cur.br - 1) * T_TOK + qtok) * 1024 + h * 128 + 4 * g;
#pragma unroll
                for (int db = 0; db < 8; ++db) { const f32x4 o = oacc[db] * inv; u32x2 w; w.x = cvt_pk_bf16(o[0], o[1]); w.y = cvt_pk_bf16(o[2], o[3]); *(u32x2*)(op + 16 * db) = w; }
                if (g == 0) lse[((size_t)(cur.br - 1) * T_TOK + qtok) * 8 + h] = lse0;
            } else {
                const float lm = fmaxf(lse0, fmaxf(l1, l2));
                const float w0 = __builtin_amdgcn_exp2f(lse0 - lm), w1 = __builtin_amdgcn_exp2f(l1 - lm), w2 = __builtin_amdgcn_exp2f(l2 - lm);
                const float wi = 1.0f / (w0 + w1 + w2), a0 = w0 * wi * inv, a1 = w1 * wi, a2 = w2 * wi;
                float ss = 0.f;
#pragma unroll
                for (int db = 0; db < 8; ++db) {
                    f32x4 o = oacc[db] * a0;
                    o[0] += bflo(x1[db].x) * a1 + bflo(x2[db].x) * a2; o[1] += bfhi(x1[db].x) * a1 + bfhi(x2[db].x) * a2;
                    o[2] += bflo(x1[db].y) * a1 + bflo(x2[db].y) * a2; o[3] += bfhi(x1[db].y) * a1 + bfhi(x2[db].y) * a2;
                    oacc[db] = o; ss += (o[0] * o[0] + o[1] * o[1]) + (o[2] * o[2] + o[3] * o[3]);
                }
                ss += __shfl_xor(ss, 16); ss += __shfl_xor(ss, 32);
                const float rs = rsqrtf(ss * (1.0f / 128.0f) + 1e-6f);
                f32x4 ggv[8];
#pragma unroll
                for (int db = 0; db < 8; ++db) ggv[db] = *(const f32x4*)(gain + h * 128 + 16 * db + 4 * g);
#pragma unroll
                for (int db = 0; db < 8; ++db) {
                    const f32x4 gg = ggv[db];
                    const f32x4 o = oacc[db] * rs * gg;
                    u32x2 w; w.x = cvt_pk_bf16(o[0], o[1]); w.y = cvt_pk_bf16(o[2], o[3]);
                    *(u32x2*)(mixed + pg8::tiled_off((int)qtok, h * 128 + 16 * db + 4 * g, DM / 64)) = w;
                }
            }
            asm volatile("s_waitcnt lgkmcnt(0)" ::: "memory"); __builtin_amdgcn_s_barrier(); asm volatile("" ::: "memory");
            cur = nxt;
        }
    }
#undef ATTN_LOAD_BLK
#undef ATTN_STORE_BLK
#undef ATTN_LOAD_Q
}

__device__ __forceinline__ void conv_phase(const Params& p, int l) {
    const bf16_t* proj = (const bf16_t*)(p.ws + WS_PROJ);
    bf16_t* mixed = (bf16_t*)(p.ws + WS_U);
    const float* gain = p.mix_g + (size_t)l * DM; const float* cw = p.conv_w + (size_t)l * 3 * 1024;
    const int tid = opaque_tid(), wid = tid >> 6, lane = tid & 63;
    u32x2 ngb[4], ngc0[4], nhi0[4], ngc1[4], nhi1[4], ngc2[4], nhi2[4];
#define CONV_LOAD(T) do { const int pos_ = (T) & (SEQ - 1); _Pragma("unroll") for (int i = 0; i < 4; ++i) { \
            const bf16_t* pr = proj + (size_t)(T) * DIN + i * 256 + lane * 4; \
            ngb[i] = *(const u32x2*)(pr + 3072); ngc0[i] = *(const u32x2*)(pr + 4096); nhi0[i] = *(const u32x2*)(pr + 5120); \
            ngc1[i] = (u32x2){0u, 0u}; nhi1[i] = ngc1[i]; ngc2[i] = ngc1[i]; nhi2[i] = ngc1[i]; \
            if (pos_ >= 1) { ngc1[i] = *(const u32x2*)(pr - DIN + 4096); nhi1[i] = *(const u32x2*)(pr - DIN + 5120); } \
            if (pos_ >= 2) { ngc2[i] = *(const u32x2*)(pr - 2 * DIN + 4096); nhi2[i] = *(const u32x2*)(pr - 2 * DIN + 5120); } } } while (0)
    int t = blockIdx.x * 8 + wid;
    if (t < T_TOK) CONV_LOAD(t);
    for (; t < T_TOK; t += gridDim.x * 8) {
        u32x2 gb[4], gc0[4], hi0[4], gc1[4], hi1[4], gc2[4], hi2[4];
#pragma unroll
        for (int i = 0; i < 4; ++i) { gb[i] = ngb[i]; gc0[i] = ngc0[i]; hi0[i] = nhi0[i]; gc1[i] = ngc1[i]; hi1[i] = nhi1[i]; gc2[i] = ngc2[i]; hi2[i] = nhi2[i]; }
        { const int tn = t + gridDim.x * 8; if (tn < T_TOK) CONV_LOAD(tn); }
        f32x4 cw0[4], cw1[4], cw2[4], g2[4];
#pragma unroll
        for (int i = 0; i < 4; ++i) { const int col = i * 256 + lane * 4;
            cw0[i] = *(const f32x4*)(cw + col); cw1[i] = *(const f32x4*)(cw + 1024 + col); cw2[i] = *(const f32x4*)(cw + 2048 + col); g2[i] = *(const f32x4*)(gain + 1024 + col); }
#pragma unroll
        for (int i = 0; i < 4; ++i) {
            const int col = i * 256 + lane * 4;
            f32x4 c0, c1, c2, gbv;
            c0[0] = bflo(gc0[i].x) * bflo(hi0[i].x); c0[1] = bfhi(gc0[i].x) * bfhi(hi0[i].x); c0[2] = bflo(gc0[i].y) * bflo(hi0[i].y); c0[3] = bfhi(gc0[i].y) * bfhi(hi0[i].y);
            c1[0] = bflo(gc1[i].x) * bflo(hi1[i].x); c1[1] = bfhi(gc1[i].x) * bfhi(hi1[i].x); c1[2] = bflo(gc1[i].y) * bflo(hi1[i].y); c1[3] = bfhi(gc1[i].y) * bfhi(hi1[i].y);
            c2[0] = bflo(gc2[i].x) * bflo(hi2[i].x); c2[1] = bfhi(gc2[i].x) * bfhi(hi2[i].x); c2[2] = bflo(gc2[i].y) * bflo(hi2[i].y); c2[3] = bfhi(gc2[i].y) * bfhi(hi2[i].y);
            gbv[0] = bflo(gb[i].x); gbv[1] = bfhi(gb[i].x); gbv[2] = bflo(gb[i].y); gbv[3] = bfhi(gb[i].y);
            f32x4 y = gbv * (cw0[i] * c2 + cw1[i] * c1 + cw2[i] * c0);
            float s2 = (y[0] * y[0] + y[1] * y[1]) + (y[2] * y[2] + y[3] * y[3]);
#pragma unroll
            for (int sft = 16; sft >= 1; sft >>= 1) s2 += __shfl_xor(s2, sft);
            const float rs2 = rsqrtf(s2 * (1.0f / 128.0f) + 1e-6f);
            y = y * rs2 * g2[i];
            u32x2 wy; wy.x = cvt_pk_bf16(y[0], y[1]); wy.y = cvt_pk_bf16(y[2], y[3]);
            *(u32x2*)(mixed + pg8::tiled_off(t, 1024 + col, DM / 64)) = wy;
        }
    }
#undef CONV_LOAD
}

#define XB_TMO      128
#define XB_XCNT(j)  (256  + 64 * (j))
#define XB_XSUB(j)  (1280 + 64 * (j))
#define XB_XGEN(j)  (2304 + 64 * (j))
#define XB_TOP      3328
#define XB_TOPGEN   3392
#define XB_LSUB(j)  (3456 + 64 * (j))
#define XB_LGEN(j)  (3968 + 64 * (j))
#define XCD_BAR_WORDS 4480
#define XB_SPIN_CAP (1u << 22)
__device__ __forceinline__ unsigned xb_ld(unsigned* p)              { return __hip_atomic_load(p, __ATOMIC_RELAXED, __HIP_MEMORY_SCOPE_AGENT); }
__device__ __forceinline__ unsigned xb_add(unsigned* p, unsigned v) { return __hip_atomic_fetch_add(p, v, __ATOMIC_RELAXED, __HIP_MEMORY_SCOPE_AGENT); }
#define XB_SPIN(cond, bar) do { unsigned _sp = 0; while (cond) { __builtin_amdgcn_s_sleep(1); \
    if ((++_sp & 255u) == 0u) { if (xb_ld(&(bar)[XB_TMO])) break; if (_sp > XB_SPIN_CAP) { atomicAdd(&(bar)[XB_TMO], 1u); break; } } } } while (0)
struct XcdBarrier { unsigned* bar; unsigned x; volatile LAS unsigned* st; };
__device__ __forceinline__ void xcd_barrier_complete(unsigned* bar, unsigned x, unsigned& nloc, unsigned& nx) {
    const unsigned G = gridDim.x * gridDim.y * gridDim.z;
    unsigned sum, cnt, mine, sp = 0u;
    for (;;) {
        sum = 0u; cnt = 0u; mine = 0u;
#pragma unroll
        for (unsigned j = 0; j < 16; ++j) { const unsigned c = xb_ld(&bar[XB_XCNT(j)]); sum += c; cnt += (c > 0u) ? 1u : 0u; mine = (j == x) ? c : mine; }
        if (sum == G) break;
        __builtin_amdgcn_s_sleep(1);
        if ((++sp & 255u) == 0u) { if (xb_ld(&bar[XB_TMO])) break; if (sp > XB_SPIN_CAP) { atomicAdd(&bar[XB_TMO], 1u); break; } }
    }
    nloc = mine > 0u ? mine : 1u; nx = cnt > 0u ? cnt : 1u;
}
__device__ __forceinline__ void xcd_barrier(const XcdBarrier& b) {
    asm volatile("s_waitcnt vmcnt(0)" ::: "memory");
    __syncthreads();
    if (threadIdx.x == 0) {
        unsigned* bar = b.bar;
        __builtin_amdgcn_s_waitcnt(0);
        unsigned nloc = b.st[0], nx = b.st[1];
        if (nloc == 0u) { xcd_barrier_complete(bar, b.x, nloc, nx); b.st[0] = nloc; b.st[1] = nx; }
        const unsigned old = xb_add(&bar[XB_XSUB(b.x)], 1u);
        const unsigned gen = old / nloc;
        if (old + 1u == (gen + 1u) * nloc) {
            __builtin_amdgcn_fence(__ATOMIC_RELEASE, "agent");
            asm volatile("s_waitcnt vmcnt(0)" ::: "memory");
            const unsigned og = xb_add(&bar[XB_TOP], 1u);
            const unsigned tg = og / nx;
            if (og + 1u == (tg + 1u) * nx) xb_add(&bar[XB_TOPGEN], 1u);
            else XB_SPIN(xb_ld(&bar[XB_TOPGEN]) == tg, bar);
            __builtin_amdgcn_fence(__ATOMIC_ACQUIRE, "agent");
            xb_add(&bar[XB_XGEN(b.x)], 1u);
            asm volatile("s_waitcnt vmcnt(0)" ::: "memory");
        } else {
            XB_SPIN(xb_ld(&bar[XB_XGEN(b.x)]) == gen, bar);
            __builtin_amdgcn_fence(__ATOMIC_ACQUIRE, "agent");
            asm volatile("s_waitcnt vmcnt(0)" ::: "memory");
        }
    }
    __syncthreads();
}

__device__ __forceinline__ void xcd_local_barrier(const XcdBarrier& b, unsigned nloc) {
    asm volatile("s_waitcnt vmcnt(0)" ::: "memory");
    __syncthreads();
    if (threadIdx.x == 0) {
        unsigned* bar = b.bar;
        __builtin_amdgcn_s_waitcnt(0);
        const unsigned old = xb_add(&bar[XB_LSUB(b.x)], 1u);
        const unsigned gen = old / nloc;
        if (old + 1u == (gen + 1u) * nloc) xb_add(&bar[XB_LGEN(b.x)], 1u);
        else XB_SPIN(xb_ld(&bar[XB_LGEN(b.x)]) == gen, bar);
        __builtin_amdgcn_fence(__ATOMIC_ACQUIRE, "agent");
        asm volatile("s_waitcnt vmcnt(0)" ::: "memory");
    }
    __syncthreads();
}

__global__ void __launch_bounds__(512, 2) fwd_megakernel(Params p) {
    extern __shared__ __attribute__((aligned(16))) unsigned char shm[];
    LAS unsigned char* lds = (LAS unsigned char*)shm;
    const float* mod = (const float*)(p.ws + WS_MOD);
    bf16_t* zb = (bf16_t*)(p.ws + WS_ZB);
    int vc = blockIdx.x, myrank = 0; bool xlocal = false;
    unsigned* bar = (unsigned*)(p.ws + WS_CTL);
    XcdBarrier xb; xb.bar = bar; xb.x = (unsigned)__builtin_amdgcn_s_getreg((3 << 11) | 20) & 0xFu; xb.st = (volatile LAS unsigned*)(lds + LDS_ST);
    const bool fused = (p.ph_hi - p.ph_lo) > 1;
    if (p.never) cg::this_grid().sync();
    if (fused) {
        if (threadIdx.x == 0) { xb.st[0] = 0u; xb.st[1] = 0u; xb.st[2] = xb_add(&bar[XB_XCNT(xb.x)], 1u); }
        __syncthreads();
        myrank = (int)xb.st[2];
    }
    for (int ph = p.ph_lo; ph < p.ph_hi; ++ph) {
        if (ph > p.ph_lo) {
            const int sb = (ph - 2) & 7;
            if (ph >= 2 && xlocal && sb >= 4) xcd_local_barrier(xb, gridDim.x / 8); else xcd_barrier(xb);
        }
        if (ph == 1 && fused) {
            unsigned cc[16];
#pragma unroll
            for (int i = 0; i < 16; ++i) cc[i] = xb_ld(&bar[XB_XCNT(i)]);
            unsigned bad = gridDim.x & 7u;
#pragma unroll
            for (int i = 0; i < 16; ++i) bad |= cc[i] ^ (i < 8 ? gridDim.x / 8 : 0u);
            if (bad == 0u) { vc = myrank * 8 + (int)xb.x; xlocal = gridDim.x == 256; }
        }
        if (ph == 0) { pro_a_phase(p, lds); continue; }
        if (ph == 1) { row_phase<false>(p.x, zb, nullptr, nullptr, nullptr, mod, 1 * DM, 0, (bf16_t*)(p.ws + WS_U), nullptr, -1); continue; }
        const int l = (ph - 2) >> 3, s = (ph - 2) & 7;
        const float* modl = mod + (size_t)l * 4 * 6 * DM;
        float* stats = (float*)(p.ws + WS_STATS);
        const int rown = gridDim.x == 256 ? (vc & 7) * 2048 + (vc >> 3) * 64 : -1;
        pg8::StaticOrder S;
        if (s == 0) {
            pg8::Gemm g{(const bf16_t*)(p.ws + WS_U), (const bf16_t*)(p.ws + WS_WT_IN) + (size_t)l * DIN * LDU, T_TOK, DIN, DM, LDU, LDU};
            S.init(g.M, g.N, gridDim.x, vc);
            pg8::EpiProj E{(bf16_t*)(p.ws + WS_PROJ), (const float*)(p.ws + WS_COS), (const float*)(p.ws + WS_SIN)};
            pg8::gemm_phase<pg8::EpiProj>(lds, g, S, E);
        } else if (s == 1) {
            attn_phase(p, lds, l, 0); conv_phase(p, l);
        } else if (s == 2) {
            attn_phase(p, lds, l, 1);
        } else if (s == 3 || s == 6) {
            pg8::Gemm g; pg8::EpiRes E;
            if (s == 3) { g = pg8::Gemm{(const bf16_t*)(p.ws + WS_U), (const bf16_t*)(p.ws + WS_WT_OUT) + (size_t)l * DM * LDU, T_TOK, DM, DM, LDU, LDU};
                          E = pg8::EpiRes{zb, modl + 2 * DM, l == 0 ? nullptr : stats, p.ln2_g + (size_t)(l - (l > 0)) * DM, p.ln2_b + (size_t)(l - (l > 0)) * DM}; }
            else        { g = pg8::Gemm{(const bf16_t*)(p.ws + WS_H), (const bf16_t*)(p.ws + WS_WT_FF2) + (size_t)l * DM * LDH, T_TOK, DM, DFF, LDH, LDH};
                          E = pg8::EpiRes{zb, modl + 5 * DM, stats, p.ln1_g + (size_t)l * DM, p.ln1_b + (size_t)l * DM}; }
            S.init(g.M, g.N, gridDim.x, vc, 4);
            pg8::gemm_phase<pg8::EpiRes>(lds, g, S, E);
        } else if (s == 4 || s == 7) {
            if (s == 4) row_phase<true>(nullptr, zb, p.out, p.ln1_g + (size_t)l * DM, p.ln1_b + (size_t)l * DM, modl, 4 * DM, 3 * DM, (bf16_t*)(p.ws + WS_U), stats, rown);
            else        row_phase<true>(nullptr, zb, p.out, p.ln2_g + (size_t)l * DM, p.ln2_b + (size_t)l * DM, modl + (size_t)4 * 6 * DM, 1 * DM, 0, (l + 1 < NLAYER) ? (bf16_t*)(p.ws + WS_U) : nullptr, (l + 1 < NLAYER) ? stats : nullptr, rown);
        } else {
            pg8::Gemm g{(const bf16_t*)(p.ws + WS_U), (const bf16_t*)(p.ws + WS_WT_FF1) + (size_t)l * DFF * LDU, T_TOK, DFF, DM, LDU, LDU};
            S.init(g.M, g.N, gridDim.x, vc);
            pg8::EpiFF1 E{(bf16_t*)(p.ws + WS_H)};
            pg8::gemm_phase<pg8::EpiFF1>(lds, g, S, E);
        }
    }
}

constexpr int N_PHASES = 2 + 8 * NLAYER;

extern "C" void kernel_launch(void* const* d_in, const int* in_sizes, int n_in, void* d_out, int out_size, void* d_ws, size_t ws_size, hipStream_t stream) {
    static int grid = 0;
    if (grid == 0) {
        int dev = 0, cus = 0, per_cu = 0;
        (void)hipGetDevice(&dev);
        (void)hipDeviceGetAttribute(&cus, hipDeviceAttributeMultiprocessorCount, dev);
        if (hipFuncSetAttribute((const void*)fwd_megakernel, hipFuncAttributeMaxDynamicSharedMemorySize, LDS_BYTES) != hipSuccess) fprintf(stderr, "hipFuncSetAttribute failed\n");
        if (hipOccupancyMaxActiveBlocksPerMultiprocessor(&per_cu, (const void*)fwd_megakernel, 512, LDS_BYTES) != hipSuccess || per_cu < 1) per_cu = 1;
        (void)hipGetLastError();
        grid = cus * per_cu;
        if (ws_size < WS_END) fprintf(stderr, "workspace too small: %zu < %zu\n", ws_size, (size_t)WS_END);
    }
    Params p{};
    p.x = (const float*)d_in[0]; p.c = (const float*)d_in[1]; p.w_in = (const float*)d_in[2]; p.conv_w = (const float*)d_in[3]; p.mix_g = (const float*)d_in[4];
    p.w_out = (const float*)d_in[5]; p.w_mod = (const float*)d_in[6]; p.b_mod = (const float*)d_in[7]; p.ln1_g = (const float*)d_in[8]; p.ln1_b = (const float*)d_in[9];
    p.w_ff1 = (const float*)d_in[10]; p.w_ff2 = (const float*)d_in[11]; p.ln2_g = (const float*)d_in[12]; p.ln2_b = (const float*)d_in[13];
    p.out = (float*)d_out; p.ws = (unsigned char*)d_ws;
#if SINGLE_LAUNCH
    (void)hipMemsetAsync((unsigned char*)d_ws + WS_CTL, 0, 20480, stream);
    p.ph_lo = 0; p.ph_hi = N_PHASES;
    void* args[] = {&p};
    hipError_t e = hipLaunchCooperativeKernel((const void*)fwd_megakernel, dim3(grid), dim3(512), args, LDS_BYTES, stream);
    if (e != hipSuccess) fprintf(stderr, "cooperative launch failed: %s (grid %d)\n", hipGetErrorString(e), grid);
#else
    for (int ph = 0; ph < N_PHASES; ++ph) {
        p.ph_lo = ph; p.ph_hi = ph + 1;
        hipLaunchKernelGGL(fwd_megakernel, dim3(grid), dim3(512), LDS_BYTES, stream, p);
    }
#endif
}
```

```cpp
#include <hip/hip_runtime.h>
#include <hip/hip_cooperative_groups.h>
#include <cstdio>
namespace cg = cooperative_groups;

#ifndef SINGLE_LAUNCH
#define SINGLE_LAUNCH 1
#endif

#define LAS __attribute__((address_space(3)))
typedef unsigned short bf16_t;
typedef short bf16x8 __attribute__((ext_vector_type(8)));
typedef short s16x4 __attribute__((ext_vector_type(4)));
typedef float f32x4 __attribute__((ext_vector_type(4)));
typedef float f32x2 __attribute__((ext_vector_type(2)));
typedef unsigned u32x4 __attribute__((ext_vector_type(4)));
typedef unsigned u32x2 __attribute__((ext_vector_type(2)));

constexpr int T_TOK = 16384, SEQ = 4096, DM = 2048, DIN = 6144, DFF = 8192, NLAYER = 2;
constexpr int KPAD = 0, LDU = DM + KPAD, LDH = DFF + KPAD;
constexpr float ALPHA = 1.4142135623730951f;
constexpr float QSCALE = 0.08838834764831845f * 1.4426950408889634f;

constexpr size_t WS_WT_IN = 0;
constexpr size_t WS_WT_OUT = WS_WT_IN + (size_t)NLAYER * DIN * LDU * 2;
constexpr size_t WS_WT_FF1 = WS_WT_OUT + (size_t)NLAYER * DM * LDU * 2;
constexpr size_t WS_WT_FF2 = WS_WT_FF1 + (size_t)NLAYER * DFF * LDU * 2;
constexpr size_t WS_MOD = WS_WT_FF2 + (size_t)NLAYER * DM * LDH * 2;
constexpr size_t WS_COS = WS_MOD + (size_t)NLAYER * 4 * 6 * DM * 4;
constexpr size_t WS_SIN = WS_COS + (size_t)SEQ * 64 * 4;
constexpr size_t WS_U = WS_SIN + (size_t)SEQ * 64 * 4;
constexpr size_t WS_PROJ = WS_U + (size_t)T_TOK * LDU * 2;
constexpr size_t WS_OPART = WS_PROJ + (size_t)T_TOK * DIN * 2;
constexpr size_t WS_LSE = WS_OPART + (size_t)3 * T_TOK * 1024 * 4;
constexpr size_t WS_CTL = WS_LSE + (size_t)3 * T_TOK * 8 * 4;
constexpr size_t WS_STATS = WS_CTL + 20480;
constexpr size_t WS_END = WS_STATS + (size_t)T_TOK * 2 * 4;
constexpr size_t WS_ZB = WS_OPART + (size_t)2 * T_TOK * 1024 * 2;
constexpr size_t WS_H = WS_PROJ;

constexpr int LDS_ST = 256 * 272 + 256 * 288;
constexpr int LDS_BYTES = LDS_ST + 16;

struct Params {
    const float* x; const float* c; const float* w_in; const float* conv_w; const float* mix_g; const float* w_out;
    const float* w_mod; const float* b_mod; const float* ln1_g; const float* ln1_b; const float* w_ff1; const float* w_ff2;
    const float* ln2_g; const float* ln2_b;
    float* out; unsigned char* ws;
    int ph_lo, ph_hi, never, pad;
};

__device__ __forceinline__ unsigned cvt_pk_bf16(float lo, float hi) { unsigned r; asm volatile("v_cvt_pk_bf16_f32 %0, %1, %2" : "=v"(r) : "v"(lo), "v"(hi)); return r; }
__device__ __forceinline__ int opaque_tid() { int t = threadIdx.x; asm volatile("" : "+v"(t)); return t; }
__device__ __forceinline__ float bf2f(unsigned short b) { return __uint_as_float(((unsigned)b) << 16); }
__device__ __forceinline__ float bflo(unsigned w) { return __uint_as_float(w << 16); }
__device__ __forceinline__ float bfhi(unsigned w) { return __uint_as_float(w & 0xffff0000u); }

namespace pg8 {
constexpr int BM = 256, BK = 64, HALF = 128, HTB = HALF * BK * 2, STAGE_BYTES = 8 * HTB, NXCD = 8, WGM = 8;
__device__ __forceinline__ int lds_byte(int r, int c) { const int st = (r >> 4) * 2 + (c >> 5), rr = r & 15, cc = c & 31, ob = rr * 64 + cc * 2; return st * 1024 + (ob ^ (((ob >> 9) & 1) << 5)); }
__device__ __forceinline__ void stage_rc(int b, int& R, int& C) { const int st = b / 1024, sb = b % 1024, swz = sb ^ (((sb >> 9) & 1) << 5); R = (st >> 1) * 16 + swz / 64; C = (st & 1) * 32 + (swz % 64) / 2; }
__device__ __forceinline__ int perm32(int rho) { const int n = rho >> 4, i = rho & 15; return 8 * (i >> 2) + 4 * n + (i & 3); }
__device__ __forceinline__ int bperm(int mode, int R) {
    if (mode == 1) return (R & ~31) + perm32(R & 31);
    if (mode == 2) return 64 * ((R >> 4) & 1) + 16 * (R >> 5) + (R & 15);
    return R;
}
__device__ __forceinline__ int bperm_inv(int mode, int s) {
    if (mode == 1) { const int t = s & 31; return (s & ~31) + 16 * ((t >> 2) & 1) + 4 * (t >> 3) + (t & 3); }
    if (mode == 2) return 32 * ((s >> 4) & 3) + 16 * (s >> 6) + (s & 15);
    return s;
}
__device__ __forceinline__ size_t tiled_off(int row, int k, int nkt) {
    return ((size_t)((row >> 7) * nkt + (k >> 6)) << 13) + (size_t)(lds_byte(row & 127, k & 63) >> 1);
}
struct Unit { int pm, pn; };
struct Gemm { const bf16_t* A; const bf16_t* Bt; int M, N, K, lda, ldb; };
struct StaticOrder {
    int nM, nN, nwg, G, c, wgm;
    __device__ void init(int M, int N, int G_, int c_, int wgm_ = WGM) { nM = M / BM; nN = N / BM; nwg = nM * nN; G = G_; c = c_; wgm = wgm_; }
    __device__ bool next(int i, Unit& u) const {
        const long L = (long)i * G + c; if (L >= nwg) return false;
        int wgid = (int)L; { const int q = nwg / NXCD, r = nwg % NXCD, xcd = wgid % NXCD, off = wgid / NXCD; wgid = (xcd < r ? xcd * (q + 1) : r * (q + 1) + (xcd - r) * q) + off; }
        const int nig = wgm * nN, gid = wgid / nig, fm = gid * wgm, gsz = (nM - fm) < wgm ? (nM - fm) : wgm;
        u.pm = fm + ((wgid % nig) % gsz); u.pn = (wgid % nig) / gsz; return true;
    }
};

template <class Epi>
__device__ __forceinline__ void gemm_phase(LAS unsigned char* lds, const Gemm g, const StaticOrder& S, const Epi& E) {
    const int tid = opaque_tid(), wid = __builtin_amdgcn_readfirstlane(tid >> 6), lane = tid & 63, wr = wid >> 2, wc = wid & 3, fr = lane & 15, fq = lane >> 4;
    const int K = g.K, nt = K / BK;
    unsigned voffA[2], voffB[2];
#pragma unroll
    for (int i = 0; i < 2; ++i) { voffA[i] = (unsigned)(tid * 16 + i * 8192); voffB[i] = voffA[i]; }
    const size_t kstep = (size_t)HTB;
    const size_t hstepA = (size_t)nt * HTB, hstepB = hstepA;
    const size_t tstepA = 2 * hstepA, tstepB = tstepA;
    const unsigned ldsw = (unsigned)wid * 1024u;
    const int aoff = lds_byte(wr * 64 + fr, fq * 8), boff = lds_byte(wc * 32 + fr, fq * 8);
#define PG8_SA(b, h) (((b) * 2 + (h)) * HTB)
#define PG8_SB(b, h) ((4 + (b) * 2 + (h)) * HTB)
#define PG8_STAGE(bufoff, gbase, voff) do { _Pragma("unroll") for (int _i = 0; _i < 2; ++_i) \
        __builtin_amdgcn_global_load_lds((const unsigned*)((const char*)(gbase) + (voff)[_i]), (LAS unsigned*)(lds + (bufoff) + ldsw + _i * 8192), 16, 0, 0); } while (0)
#define PG8_LDA(dst, b, h) do { _Pragma("unroll") for (int m = 0; m < 4; ++m) _Pragma("unroll") for (int k = 0; k < 2; ++k) dst[m][k] = *(const LAS bf16x8*)(lds + PG8_SA(b, h) + aoff + m * 2048 + k * 1024); } while (0)
#define PG8_LDB(dst, b, h) do { _Pragma("unroll") for (int n = 0; n < 2; ++n) _Pragma("unroll") for (int k = 0; k < 2; ++k) dst[n][k] = *(const LAS bf16x8*)(lds + PG8_SB(b, h) + boff + n * 2048 + k * 1024); } while (0)
#define PG8_MMA(ai, bj, At, Bt) do { __builtin_amdgcn_s_setprio(1); _Pragma("unroll") for (int m = 0; m < 4; ++m) _Pragma("unroll") for (int n = 0; n < 2; ++n) _Pragma("unroll") for (int k = 0; k < 2; ++k) \
        acc[ai][bj][m][n] = __builtin_amdgcn_mfma_f32_16x16x32_bf16(Bt[n][k], At[m][k], acc[ai][bj][m][n], 0, 0, 0); __builtin_amdgcn_s_setprio(0); } while (0)
#define PG8_WAIT_V(n) asm volatile("s_waitcnt vmcnt(" #n ")" ::: "memory")
#define PG8_WAIT_L(n) asm volatile("s_waitcnt lgkmcnt(" #n ")" ::: "memory")
#define PG8_BAR __builtin_amdgcn_s_barrier()
#define PG8_SCHED __builtin_amdgcn_sched_barrier(0)
    Unit cur, nxt; int ui = 0;
    if (!S.next(0, cur)) return;
    f32x4 acc[2][2][4][2];
#pragma unroll
    for (int a = 0; a < 2; ++a)
#pragma unroll
        for (int b = 0; b < 2; ++b)
#pragma unroll
            for (int m = 0; m < 4; ++m)
#pragma unroll
                for (int n = 0; n < 2; ++n) acc[a][b][m][n] = (f32x4){0.f, 0.f, 0.f, 0.f};
    bf16x8 At[4][2], B0[2][2], B1[2][2];
    const char* cA = (const char*)g.A + (size_t)cur.pm * tstepA; const char* cB = (const char*)g.Bt + (size_t)cur.pn * tstepB;
    PG8_STAGE(PG8_SB(0, 0), cB, voffB); PG8_STAGE(PG8_SA(0, 0), cA, voffA); PG8_STAGE(PG8_SB(0, 1), cB + hstepB, voffB); PG8_STAGE(PG8_SA(0, 1), cA + hstepA, voffA);
    if (wr == 1) PG8_BAR;
    PG8_WAIT_V(4); PG8_BAR;
    PG8_STAGE(PG8_SB(1, 0), cB + kstep, voffB); PG8_STAGE(PG8_SA(1, 0), cA + kstep, voffA); PG8_STAGE(PG8_SB(1, 1), cB + hstepB + kstep, voffB);
    PG8_WAIT_V(6); PG8_BAR;
    for (;;) {
        const bool has_next = S.next(ui + 1, nxt);
        const char* nA = has_next ? (const char*)g.A + (size_t)nxt.pm * tstepA : cA; const char* nB = has_next ? (const char*)g.Bt + (size_t)nxt.pn * tstepB : cB;
        for (int t = 0; t < nt; t += 2) {
            const bool last = (t == nt - 2);
            const char* a1 = cA + (size_t)(t + 1) * kstep;
            const char* a2 = last ? nA : cA + (size_t)(t + 2) * kstep; const char* b2 = last ? nB : cB + (size_t)(t + 2) * kstep;
            const char* a3 = a2 + kstep; const char* b3 = b2 + kstep;
            PG8_LDB(B0, 0, 0); PG8_SCHED; PG8_LDA(At, 0, 0); PG8_STAGE(PG8_SA(1, 1), a1 + hstepA, voffA);
            PG8_WAIT_L(8); PG8_BAR; PG8_WAIT_L(0); PG8_MMA(0, 0, At, B0); PG8_BAR; PG8_SCHED;
            PG8_LDB(B1, 0, 1); PG8_STAGE(PG8_SB(0, 0), b2, voffB);
            PG8_BAR; PG8_WAIT_L(0); PG8_MMA(0, 1, At, B1); PG8_BAR;
            PG8_LDA(At, 0, 1); PG8_STAGE(PG8_SA(0, 0), a2, voffA);
            PG8_BAR; PG8_WAIT_L(0); PG8_MMA(1, 0, At, B0); PG8_BAR; PG8_SCHED;
            PG8_STAGE(PG8_SB(0, 1), b2 + hstepB, voffB);
            PG8_WAIT_V(6); PG8_BAR; PG8_MMA(1, 1, At, B1); PG8_BAR;
            PG8_LDB(B0, 1, 0); PG8_SCHED; PG8_LDA(At, 1, 0); PG8_STAGE(PG8_SA(0, 1), a2 + hstepA, voffA);
            PG8_WAIT_L(8); PG8_BAR; PG8_WAIT_L(0); PG8_MMA(0, 0, At, B0); PG8_BAR; PG8_SCHED;
            PG8_LDB(B1, 1, 1); PG8_STAGE(PG8_SB(1, 0), b3, voffB);
            PG8_BAR; PG8_WAIT_L(0); PG8_MMA(0, 1, At, B1); PG8_BAR;
            PG8_LDA(At, 1, 1); PG8_STAGE(PG8_SA(1, 0), a3, voffA);
            PG8_BAR; PG8_WAIT_L(0); PG8_MMA(1, 0, At, B0); PG8_BAR; PG8_SCHED;
            PG8_STAGE(PG8_SB(1, 1), b3 + hstepB, voffB);
            PG8_WAIT_V(6); PG8_BAR; PG8_MMA(1, 1, At, B1); PG8_BAR;
        }
        E(acc, cur, wr, wc, fr, fq);
        if (!has_next) break;
#pragma unroll
        for (int a = 0; a < 2; ++a)
#pragma unroll
            for (int b = 0; b < 2; ++b)
#pragma unroll
                for (int m = 0; m < 4; ++m)
#pragma unroll
                    for (int n = 0; n < 2; ++n) acc[a][b][m][n] = (f32x4){0.f, 0.f, 0.f, 0.f};
        cur = nxt; cA = nA; cB = nB; ++ui;
    }
    PG8_WAIT_V(0);
    if (wr == 0) PG8_BAR;
    PG8_BAR;
#undef PG8_SA
#undef PG8_SB
#undef PG8_STAGE
#undef PG8_LDA
#undef PG8_LDB
#undef PG8_MMA
#undef PG8_WAIT_V
#undef PG8_WAIT_L
#undef PG8_BAR
#undef PG8_SCHED
}

struct EpiProj {
    static constexpr int PERM = 2;
    bf16_t* O; const float* cosT; const float* sinT;
    __device__ __forceinline__ void operator()(const f32x4 (&acc)[2][2][4][2], const Unit& u, int wr, int wc, int fr, int fq) const {
        const int row0 = u.pm * BM + wr * 64 + fr, j0 = wc * 16 + 4 * fq, colb = u.pn * BM + j0;
        if (u.pn < 8) {
            const float sc = (u.pn < 4) ? QSCALE : 1.0f;
#pragma unroll
            for (int ai = 0; ai < 2; ++ai) {
                f32x4 csv[4], snv[4];
#pragma unroll
                for (int m = 0; m < 4; ++m) { const int pos = (row0 + ai * HALF + m * 16) & (SEQ - 1); csv[m] = *(const f32x4*)(cosT + pos * 64 + j0); snv[m] = *(const f32x4*)(sinT + pos * 64 + j0); }
#pragma unroll
                for (int m = 0; m < 4; ++m) {
                    const int row = row0 + ai * HALF + m * 16;
                    const f32x4 cs = csv[m], sn = snv[m];
                    bf16_t* rowp = O + (size_t)row * DIN + colb;
#pragma unroll
                    for (int bj = 0; bj < 2; ++bj) {
                        const f32x4 a = acc[ai][bj][m][0], b = acc[ai][bj][m][1];
                        const f32x4 o1 = (a * cs - b * sn) * sc, o2 = (b * cs + a * sn) * sc;
                        u32x2 w1, w2; w1.x = cvt_pk_bf16(o1[0], o1[1]); w1.y = cvt_pk_bf16(o1[2], o1[3]); w2.x = cvt_pk_bf16(o2[0], o2[1]); w2.y = cvt_pk_bf16(o2[2], o2[3]);
                        *(u32x2*)(rowp + bj * HALF) = w1; *(u32x2*)(rowp + bj * HALF + 64) = w2;
                    }
                }
            }
        } else {
#pragma unroll
            for (int ai = 0; ai < 2; ++ai)
#pragma unroll
                for (int m = 0; m < 4; ++m) {
                    const int row = row0 + ai * HALF + m * 16;
                    bf16_t* rowp = O + (size_t)row * DIN + colb;
#pragma unroll
                    for (int bj = 0; bj < 2; ++bj) {
                        const f32x4 o1 = acc[ai][bj][m][0], o2 = acc[ai][bj][m][1];
                        u32x2 w1, w2; w1.x = cvt_pk_bf16(o1[0], o1[1]); w1.y = cvt_pk_bf16(o1[2], o1[3]); w2.x = cvt_pk_bf16(o2[0], o2[1]); w2.y = cvt_pk_bf16(o2[2], o2[3]);
                        *(u32x2*)(rowp + bj * HALF) = w1; *(u32x2*)(rowp + bj * HALF + 64) = w2;
                    }
                }
        }
    }
};
struct EpiRes {
    static constexpr int PERM = 1;
    bf16_t* z; const float* gate;
    const float* stats; const float* lng; const float* lnb;
    __device__ __forceinline__ void operator()(const f32x4 (&acc)[2][2][4][2], const Unit& u, int wr, int wc, int fr, int fq) const {
        const int row0 = u.pm * BM + wr * 64 + fr, col0 = u.pn * BM + wc * 32 + 8 * fq;
        const float* gb = gate + (size_t)(row0 >> 12) * (6 * DM);
        const bool ln = stats != nullptr;
        constexpr int GB[4] = {0, 4, 8, 16};
        f32x2 st[4];
#pragma unroll
        for (int grp = 0; grp < 3; ++grp) {
            u32x4 xv[8]; f32x4 cg[2][2], cl[2][2], cb[2][2];
            if (grp == 0 || grp == 2) {
#pragma unroll
                for (int m = 0; m < 4; ++m) st[m] = ln ? *(const f32x2*)(stats + 2 * (row0 + (grp ? HALF : 0) + m * 16)) : (f32x2){0.f, 1.f};
            }
#pragma unroll
            for (int j = GB[grp]; j < GB[grp + 1]; ++j) {
                const int k = j >> 2, m = j & 3, ai = k >> 1, col = col0 + (k & 1) * HALF, kk = k - (GB[grp] >> 2);
                if (m == 0) {
#pragma unroll
                    for (int n = 0; n < 2; ++n) { cg[kk][n] = *(const f32x4*)(gb + col + 4 * n) + 1.0f; cl[kk][n] = (f32x4){1.f, 1.f, 1.f, 1.f}; cb[kk][n] = (f32x4){0.f, 0.f, 0.f, 0.f};
                        if (ln) { cl[kk][n] = *(const f32x4*)(lng + col + 4 * n); cb[kk][n] = *(const f32x4*)(lnb + col + 4 * n); } }
                }
                xv[j - GB[grp]] = *(const u32x4*)(z + (size_t)(row0 + ai * HALF + m * 16) * DM + col);
            }
#pragma unroll
            for (int j = GB[grp]; j < GB[grp + 1]; ++j) {
                const int k = j >> 2, m = j & 3, ai = k >> 1, bj = k & 1, col = col0 + bj * HALF, kk = k - (GB[grp] >> 2);
                const u32x4 r = xv[j - GB[grp]];
                f32x4 x0 = {bflo(r.x), bfhi(r.x), bflo(r.y), bfhi(r.y)}, x1 = {bflo(r.z), bfhi(r.z), bflo(r.w), bfhi(r.w)};
                x0 = (x0 - st[m].x) * st[m].y * cl[kk][0] + cb[kk][0]; x1 = (x1 - st[m].x) * st[m].y * cl[kk][1] + cb[kk][1];
                const f32x4 o0 = x0 * ALPHA + cg[kk][0] * acc[ai][bj][m][0], o1 = x1 * ALPHA + cg[kk][1] * acc[ai][bj][m][1];
                u32x4 w; w.x = cvt_pk_bf16(o0[0], o0[1]); w.y = cvt_pk_bf16(o0[2], o0[3]); w.z = cvt_pk_bf16(o1[0], o1[1]); w.w = cvt_pk_bf16(o1[2], o1[3]);
                *(u32x4*)(z + (size_t)(row0 + ai * HALF + m * 16) * DM + col) = w;
            }
        }
    }
};
struct EpiFF1 {
    static constexpr int PERM = 1;
    bf16_t* O;
    __device__ __forceinline__ void operator()(const f32x4 (&acc)[2][2][4][2], const Unit& u, int wr, int wc, int fr, int fq) const {
        const int row0 = u.pm * BM + wr * 64 + fr, col0 = u.pn * BM + wc * 32 + 8 * fq;
#pragma unroll
        for (int ai = 0; ai < 2; ++ai)
#pragma unroll
            for (int m = 0; m < 4; ++m) {
                const int rowi = row0 + ai * HALF + m * 16;
#pragma unroll
                for (int bj = 0; bj < 2; ++bj) {
                    f32x4 v0 = acc[ai][bj][m][0], v1 = acc[ai][bj][m][1];
#pragma unroll
                    for (int j = 0; j < 4; ++j) { const float a = fmaxf(v0[j], 0.f), b = fmaxf(v1[j], 0.f); v0[j] = a * a; v1[j] = b * b; }
                    u32x4 w; w.x = cvt_pk_bf16(v0[0], v0[1]); w.y = cvt_pk_bf16(v0[2], v0[3]); w.z = cvt_pk_bf16(v1[0], v1[1]); w.w = cvt_pk_bf16(v1[2], v1[3]);
                    *(u32x4*)(O + tiled_off(rowi, col0 + bj * HALF, DFF / 64)) = w;
                }
            }
    }
};
}

__device__ __forceinline__ void pro_a_phase(const Params& p, LAS unsigned char* lds) {
    const int tid = opaque_tid();
    LAS float* cond = (LAS float*)lds;
    LAS float* red = (LAS float*)(lds + 32768);
    LAS float* tile = (LAS float*)(lds + 65536);
    float* mod = (float*)(p.ws + WS_MOD);
    const int G = gridDim.x;
    constexpr int N_GEMV = 256, N_ROPE = 512, N_TR = 12288, FIRST_TR = N_GEMV + N_ROPE;
    if ((int)blockIdx.x < N_GEMV) {
        for (int i = tid; i < 4 * DM; i += 512) { const float v = p.c[i]; cond[i] = v / (1.0f + __expf(-v)); }
        __syncthreads();
    }
    int item = blockIdx.x;
    for (; item < FIRST_TR; item += G) {
        if (item < N_GEMV) {
            const int l = item >> 7, n0 = (item & 127) * 96, cq = tid & 31, kg = tid >> 5;
            const float* wp = p.w_mod + (size_t)l * DM * (6 * DM) + (size_t)(kg * 128) * (6 * DM) + n0 + cq * 4;
            const LAS float* cp = cond + kg * 128;
            f32x4 a0 = {0.f, 0.f, 0.f, 0.f}, a1 = a0, a2 = a0, a3 = a0;
            if (cq < 24)
#pragma unroll 8
            for (int k = 0; k < 128; ++k) {
                const f32x4 w = __builtin_nontemporal_load((const f32x4*)(wp + (size_t)k * (6 * DM)));
                a0 += w * cp[k]; a1 += w * cp[DM + k]; a2 += w * cp[2 * DM + k]; a3 += w * cp[3 * DM + k];
            }
            *(LAS f32x4*)(red + (kg * 4 + 0) * 128 + cq * 4) = a0; *(LAS f32x4*)(red + (kg * 4 + 1) * 128 + cq * 4) = a1;
            *(LAS f32x4*)(red + (kg * 4 + 2) * 128 + cq * 4) = a2; *(LAS f32x4*)(red + (kg * 4 + 3) * 128 + cq * 4) = a3;
            __syncthreads();
            { const int b = tid >> 7, col = tid & 127;
              if (col < 96) { float s = p.b_mod[l * 6 * DM + n0 + col];
#pragma unroll
                for (int k2 = 0; k2 < 16; ++k2) s += red[(k2 * 4 + b) * 128 + col];
                mod[((size_t)l * 4 + b) * (6 * DM) + n0 + col] = s; } }
            __syncthreads();
        } else {
            const int idx = (item - N_GEMV) * 512 + tid, pos = idx >> 6, j = idx & 63;
            double invd = 1.0;
#pragma nounroll
            for (int k = 0; k < j; ++k) invd *= 0.86596432336006535;
            const float inv = (float)invd;
            const float ang = (float)pos * inv;
            const double xd = (double)ang, kk = rint(xd * 0.15915494309189535), y = xd - kk * 6.283185307179586, y2 = y * y;
            double s = 1.0, c = 1.0;
#pragma nounroll
            for (int k = 13; k >= 1; --k) { s = 1.0 - s * y2 / (double)((2 * k) * (2 * k + 1)); c = 1.0 - c * y2 / (double)((2 * k - 1) * (2 * k)); }
            ((float*)(p.ws + WS_COS))[idx] = (float)c; ((float*)(p.ws + WS_SIN))[idx] = (float)(y * s);
        }
    }
    auto decode = [&](int tt, const float*& src, bf16_t*& dst, int& K, int& N, int& mode, int& n0, int& k0) {
        const int l = tt / 6144, u = tt % 6144; int v;
        if (u < 1536) { mode = 2; K = DM; N = DIN; v = u; src = p.w_in + (size_t)l * DM * DIN; dst = (bf16_t*)(p.ws + WS_WT_IN) + (size_t)l * DIN * LDU; }
        else if (u < 2048) { mode = 1; K = DM; N = DM; v = u - 1536; src = p.w_out + (size_t)l * DM * DM; dst = (bf16_t*)(p.ws + WS_WT_OUT) + (size_t)l * DM * LDU; }
        else if (u < 4096) { mode = 1; K = DM; N = DFF; v = u - 2048; src = p.w_ff1 + (size_t)l * DM * DFF; dst = (bf16_t*)(p.ws + WS_WT_FF1) + (size_t)l * DFF * LDU; }
        else { mode = 1; K = DFF; N = DM; v = u - 4096; src = p.w_ff2 + (size_t)l * DFF * DM; dst = (bf16_t*)(p.ws + WS_WT_FF2) + (size_t)l * DM * LDH; }
        const int ntn = N >> 6, kt = v / ntn, nt = v % ntn;
        src += (size_t)(kt * 128) * N + nt * 64; n0 = nt * 64; k0 = kt * 128;
    };
    const int lk = tid >> 4, ln4 = tid & 15;
    const int sn = tid >> 4, skc = tid & 15;
    int tt = item - FIRST_TR;
    if (tt < N_TR) {
        const float* src; bf16_t* dst; int K, N, mode, n0, k0; decode(tt, src, dst, K, N, mode, n0, k0);
        f32x4 rg[4];
#pragma unroll
        for (int i = 0; i < 4; ++i) rg[i] = __builtin_nontemporal_load((const f32x4*)(src + (size_t)(lk + 32 * i) * N + ln4 * 4));
        for (;;) {
#pragma unroll
            for (int i = 0; i < 4; ++i) { LAS float* tp = tile + (lk + 32 * i) * 65 + ln4 * 4; tp[0] = rg[i][0]; tp[1] = rg[i][1]; tp[2] = rg[i][2]; tp[3] = rg[i][3]; }
            asm volatile("s_waitcnt lgkmcnt(0)" ::: "memory"); __builtin_amdgcn_s_barrier(); asm volatile("" ::: "memory");
            bf16_t* cdst = dst; const int cnkt = K >> 6, cmode = mode, cn0 = n0, ck0 = k0;
            const int tn = tt + G;
            if (tn < N_TR) { decode(tn, src, dst, K, N, mode, n0, k0);
#pragma unroll
                for (int i = 0; i < 4; ++i) rg[i] = __builtin_nontemporal_load((const f32x4*)(src + (size_t)(lk + 32 * i) * N + ln4 * 4)); }
#pragma unroll
            for (int i = 0; i < 2; ++i) {
                const int n = sn + 32 * i; const LAS float* tp = tile + (skc * 8) * 65 + n;
                u32x4 w; w.x = cvt_pk_bf16(tp[0], tp[65]); w.y = cvt_pk_bf16(tp[130], tp[195]); w.z = cvt_pk_bf16(tp[260], tp[325]); w.w = cvt_pk_bf16(tp[390], tp[455]);
                const int ng = cn0 + n, np = (ng & ~127) + pg8::bperm_inv(cmode, ng & 127);
                *(u32x4*)(cdst + pg8::tiled_off(np, ck0 + skc * 8, cnkt)) = w;
            }
            asm volatile("s_waitcnt lgkmcnt(0)" ::: "memory"); __builtin_amdgcn_s_barrier(); asm volatile("" ::: "memory");
            if (tn >= N_TR) break;
            tt = tn;
        }
    }
}

template <bool DO_LN>
__device__ __forceinline__ void row_phase(const float* xin, bf16_t* zb, float* xout, const float* g, const float* bta, const float* modl, int sc_off, int sh_off, bf16_t* U, float* stats, int rbase) {
    const int tid = opaque_tid(), wid = tid >> 6, lane = tid & 63;
    const int rstep = rbase >= 0 ? 8 : (int)gridDim.x * 8, rend = rbase >= 0 ? rbase + 64 : T_TOK;
    f32x4 vn[8]; u32x2 vb[8];
    int row = (rbase >= 0 ? rbase : (int)blockIdx.x * 8) + wid;
    if (row < rend) {
#pragma unroll
        for (int i = 0; i < 8; ++i) { if (DO_LN) vb[i] = *(const u32x2*)(zb + (size_t)row * DM + lane * 4 + i * 256); else vn[i] = __builtin_nontemporal_load((const f32x4*)(xin + (size_t)row * DM + lane * 4 + i * 256)); }
    }
    for (; row < rend; row += rstep) {
        f32x4 v[8], scv[8], shv[8];
#pragma unroll
        for (int i = 0; i < 8; ++i) { if (DO_LN) v[i] = (f32x4){bflo(vb[i].x), bfhi(vb[i].x), bflo(vb[i].y), bfhi(vb[i].y)}; else v[i] = vn[i]; }
        { const int nrow = row + rstep;
          if (nrow < rend) {
#pragma unroll
              for (int i = 0; i < 8; ++i) { if (DO_LN) vb[i] = *(const u32x2*)(zb + (size_t)nrow * DM + lane * 4 + i * 256); else vn[i] = __builtin_nontemporal_load((const f32x4*)(xin + (size_t)nrow * DM + lane * 4 + i * 256)); }
          } }
        if (DO_LN) {
            float s = 0.f;
#pragma unroll
            for (int i = 0; i < 8; ++i) s += (v[i][0] + v[i][1]) + (v[i][2] + v[i][3]);
#pragma unroll
            for (int o = 32; o >= 1; o >>= 1) s += __shfl_xor(s, o);
            const float mu = s * (1.0f / DM);
            float q = 0.f;
#pragma unroll
            for (int i = 0; i < 8; ++i) { v[i] -= mu; q += (v[i][0] * v[i][0] + v[i][1] * v[i][1]) + (v[i][2] * v[i][2] + v[i][3] * v[i][3]); }
#pragma unroll
            for (int o = 32; o >= 1; o >>= 1) q += __shfl_xor(q, o);
            const float rstd = rsqrtf(q * (1.0f / DM) + 1e-5f);
            const unsigned voff = (unsigned)lane * 16u;
            {
                f32x4 gg[8], bb[8];
#pragma unroll
                for (int i = 0; i < 8; ++i) { gg[i] = *(const f32x4*)((const char*)g + (voff + (unsigned)i * 1024u)); bb[i] = *(const f32x4*)((const char*)bta + (voff + (unsigned)i * 1024u)); }
#pragma unroll
                for (int i = 0; i < 8; ++i) v[i] = v[i] * rstd * gg[i] + bb[i];
            }
            if (U) {
                const char* mb = (const char*)(modl + (size_t)(row >> 12) * (6 * DM));
#pragma unroll
                for (int i = 0; i < 8; ++i) { scv[i] = *(const f32x4*)(mb + ((unsigned)sc_off * 4u + voff + (unsigned)i * 1024u)); shv[i] = *(const f32x4*)(mb + ((unsigned)sh_off * 4u + voff + (unsigned)i * 1024u)); }
            }
            if (stats) { if (lane == 0) *(f32x2*)(stats + 2 * row) = (f32x2){mu, rstd}; }
            else {
                float* op = xout + (size_t)row * DM + lane * 4;
#pragma unroll
                for (int i = 0; i < 8; ++i) __builtin_nontemporal_store(v[i], (f32x4*)(op + i * 256));
            }
        }
        if (U) {
            if (!DO_LN) {
                const unsigned voff = (unsigned)lane * 16u;
                const char* mb = (const char*)(modl + (size_t)(row >> 12) * (6 * DM));
#pragma unroll
                for (int i = 0; i < 8; ++i) { scv[i] = *(const f32x4*)(mb + ((unsigned)sc_off * 4u + voff + (unsigned)i * 1024u)); shv[i] = *(const f32x4*)(mb + ((unsigned)sh_off * 4u + voff + (unsigned)i * 1024u)); }
            }
#pragma unroll
            for (int i = 0; i < 8; ++i) {
                const f32x4 uu = v[i] * (scv[i] + 1.0f) + shv[i];
                u32x2 w; w.x = cvt_pk_bf16(uu[0], uu[1]); w.y = cvt_pk_bf16(uu[2], uu[3]);
                *(u32x2*)(U + pg8::tiled_off(row, i * 256 + lane * 4, DM / 64)) = w;
                if (!DO_LN) { u32x2 wz; wz.x = cvt_pk_bf16(v[i][0], v[i][1]); wz.y = cvt_pk_bf16(v[i][2], v[i][3]); *(u32x2*)(zb + (size_t)row * DM + lane * 4 + i * 256) = wz; }
            }
        }
    }
}

struct AttnStep { size_t tb; int h, dl, r, n, br, first; };
__device__ __forceinline__ AttnStep attn_step(int wg, int q, int mode) {
    AttnStep a;
    if (mode) { const int bh = wg >> 3; a.tb = (size_t)(bh >> 3) * SEQ; a.h = bh & 7; a.br = 0; a.dl = 0; a.r = 0; a.n = 4 * (wg & 7) + q; a.first = (q == 0); }
    else if (wg < 128) { a.tb = (size_t)(wg >> 5) * SEQ; a.h = (wg >> 2) & 7; a.br = 1; a.dl = 2; a.r = wg & 3; a.n = q; a.first = (q == 0); }
    else { const int c16 = (wg - 128) * 4 + (q >> 1); a.tb = (size_t)(c16 >> 7) * SEQ; a.h = (c16 >> 4) & 7; a.br = 2; a.dl = 4; a.r = c16 & 15; a.n = q & 1; a.first = !(q & 1); }
    return a;
}
__device__ __forceinline__ void attn_phase(const Params& p, LAS unsigned char* lds, int l, int mode) {
    const bf16_t* proj = (const bf16_t*)(p.ws + WS_PROJ);
    bf16_t* opart = (bf16_t*)(p.ws + WS_OPART); float* lse = (float*)(p.ws + WS_LSE);
    bf16_t* mixed = (bf16_t*)(p.ws + WS_U);
    const float* gain = p.mix_g + (size_t)l * DM;
    const int tid = opaque_tid(), wid = tid >> 6, lane = tid & 63, li = lane & 15, g = lane >> 4;
    LAS unsigned char* Kl = lds; LAS unsigned char* Vl = lds + 256 * 272;
    constexpr int KH = 128 * 272, VH = 128 * 288;
    const int nsteps = mode ? 4 : 8;
    u32x4 kv[4], vv[4]; bf16x8 qf[4];
#define ATTN_LOAD_BLK(A, NB) do { _Pragma("unroll") for (int i = 0; i < 4; ++i) { const int idx = tid + 512 * i, row = idx >> 4, ch = idx & 15; \
            const bf16_t* src = proj + ((A).tb + ((size_t)((NB) * 128 + row) << (A).dl) + (A).r) * DIN + (A).h * 128 + ch * 8; kv[i] = *(const u32x4*)(src + 1024); vv[i] = *(const u32x4*)(src + 2048); } } while (0)
#define ATTN_STORE_BLK(HH) do { _Pragma("unroll") for (int i = 0; i < 4; ++i) { const int idx = tid + 512 * i, row = idx >> 4, ch = idx & 15; \
            *(LAS u32x4*)(Kl + (HH) * KH + row * 272 + ch * 16) = kv[i]; *(LAS u32x4*)(Vl + (HH) * VH + row * 288 + ch * 16) = vv[i]; } } while (0)
#define ATTN_LOAD_Q(A) do { const size_t qt_ = (A).tb + ((size_t)((A).n * 128 + wid * 16 + li) << (A).dl) + (A).r; \
            _Pragma("unroll") for (int s = 0; s < 4; ++s) qf[s] = *(const bf16x8*)(proj + qt_ * DIN + (A).h * 128 + s * 32 + g * 8); } while (0)
    for (int wg = blockIdx.x; wg < 256; wg += gridDim.x) {
        AttnStep cur = attn_step(wg, 0, mode);
        if (mode && cur.n > 0) { ATTN_LOAD_BLK(cur, cur.n - 1); ATTN_STORE_BLK(1); }
        ATTN_LOAD_BLK(cur, cur.n); ATTN_LOAD_Q(cur);
        for (int q = 0; q < nsteps; ++q) {
            const int c = q & 1;
            if (cur.first && cur.n == 0) {
#pragma unroll
                for (int i = 0; i < 4; ++i) { const int idx = tid + 512 * i, row = idx >> 4, ch = idx & 15;
                    *(LAS u32x4*)(Kl + (c ^ 1) * KH + row * 272 + ch * 16) = (u32x4){0u, 0u, 0u, 0u}; *(LAS u32x4*)(Vl + (c ^ 1) * VH + row * 288 + ch * 16) = (u32x4){0u, 0u, 0u, 0u}; }
            }
            ATTN_STORE_BLK(c);
            bf16x8 qc[4];
#pragma unroll
            for (int s = 0; s < 4; ++s) qc[s] = qf[s];
            asm volatile("s_waitcnt lgkmcnt(0)" ::: "memory"); __builtin_amdgcn_s_barrier(); asm volatile("" ::: "memory");
            AttnStep nxt = attn_step(wg, (q + 1 < nsteps) ? q + 1 : q, mode);
            if (q + 1 < nsteps) { ATTN_LOAD_BLK(nxt, nxt.n); ATTN_LOAD_Q(nxt); }
            const int n = cur.n, dl = cur.dl, h = cur.h, mbase = (n - 1) * 128;
            const int qi = wid * 16 + li; const size_t qtok = cur.tb + ((size_t)(n * 128 + qi) << dl) + cur.r;
            const int kb0 = wid & ~1;
            const int koffP = (c ^ 1) * KH, koffC = c * KH, voffP = (c ^ 1) * VH, voffC = c * VH;
            f32x4 sacc[10];
#pragma unroll
            for (int i = 0; i < 10; ++i) {
                sacc[i] = (f32x4){0.f, 0.f, 0.f, 0.f};
                const int kb = kb0 + i, koff = (kb < 8) ? koffP + kb * (16 * 272) : koffC + (kb - 8) * (16 * 272);
#pragma unroll
                for (int s = 0; s < 4; ++s) {
                    const bf16x8 kf = *(const LAS bf16x8*)(Kl + koff + li * 272 + (32 * s + 8 * g) * 2);
                    sacc[i] = __builtin_amdgcn_mfma_f32_16x16x32_bf16(kf, qc[s], sacc[i], 0, 0, 0);
                }
            }
            float mx = -1e30f;
#pragma unroll
            for (int i = 0; i < 10; ++i)
#pragma unroll
                for (int j = 0; j < 4; ++j) {
                    const int kj = 16 * (kb0 + i) + 4 * g + j, dist = 128 + qi - kj;
                    const bool valid = (dist >= 0) && (dist <= 128) && (mbase + kj >= 0);
                    const float sv = valid ? sacc[i][j] : -1e30f;
                    sacc[i][j] = sv; mx = fmaxf(mx, sv);
                }
            mx = fmaxf(mx, __shfl_xor(mx, 16)); mx = fmaxf(mx, __shfl_xor(mx, 32));
            float lsum = 0.f;
#pragma unroll
            for (int i = 0; i < 10; ++i)
#pragma unroll
                for (int j = 0; j < 4; ++j) { const float pv = __builtin_amdgcn_exp2f(sacc[i][j] - mx); sacc[i][j] = pv; lsum += pv; }
            lsum += __shfl_xor(lsum, 16); lsum += __shfl_xor(lsum, 32);
            u32x2 x1[8], x2[8]; float l1 = 0.f, l2 = 0.f;
            if (mode) {
                l1 = lse[qtok * 8 + h]; l2 = lse[((size_t)T_TOK + qtok) * 8 + h];
                const bf16_t* p1 = opart + qtok * 1024 + h * 128 + 4 * g; const bf16_t* p2 = p1 + (size_t)T_TOK * 1024;
#pragma unroll
                for (int db = 0; db < 8; ++db) { x1[db] = *(const u32x2*)(p1 + 16 * db); x2[db] = *(const u32x2*)(p2 + 16 * db); }
            }
            f32x4 oacc[8];
#pragma unroll
            for (int db = 0; db < 8; ++db) oacc[db] = (f32x4){0.f, 0.f, 0.f, 0.f};
            const int vlane = (4 * g + (li >> 2)) * 288 + (4 * (li & 3)) * 2;
#pragma unroll
            for (int t = 0; t < 5; ++t) {
                u32x4 pw; pw.x = cvt_pk_bf16(sacc[2 * t][0], sacc[2 * t][1]); pw.y = cvt_pk_bf16(sacc[2 * t][2], sacc[2 * t][3]);
                pw.z = cvt_pk_bf16(sacc[2 * t + 1][0], sacc[2 * t + 1][1]); pw.w = cvt_pk_bf16(sacc[2 * t + 1][2], sacc[2 * t + 1][3]);
                const bf16x8 pf = __builtin_bit_cast(bf16x8, pw);
                const int kbv = kb0 + 2 * t, voff = (kbv < 8) ? voffP + kbv * (16 * 288) : voffC + (kbv - 8) * (16 * 288);
                const LAS unsigned char* vb = Vl + voff + vlane;
#pragma unroll
                for (int db = 0; db < 8; ++db) {
                    const s16x4 lo = __builtin_bit_cast(s16x4, __builtin_amdgcn_ds_read_tr16_b64_v4i16((LAS s16x4*)(vb + db * 32)));
                    const s16x4 hi = __builtin_bit_cast(s16x4, __builtin_amdgcn_ds_read_tr16_b64_v4i16((LAS s16x4*)(vb + 16 * 288 + db * 32)));
                    const bf16x8 vf = __builtin_shufflevector(lo, hi, 0, 1, 2, 3, 4, 5, 6, 7);
                    oacc[db] = __builtin_amdgcn_mfma_f32_16x16x32_bf16(vf, pf, oacc[db], 0, 0, 0);
                }
            }
            const float inv = 1.0f / lsum, lse0 = mx + __builtin_amdgcn_logf(lsum);
            if (mode == 0) {
                bf16_t* op = opart + ((size_t)(cur.br - 1) * T_TOK + qtok) * 1024 + h * 128 + 4 * g;
#pragma unroll
                for (int db = 0; db < 8; ++db) { const f32x4 o = oacc[db] * inv; u32x2 w; w.x = cvt_pk_bf16(o[0], o[1]); w.y = cvt_pk_bf16(o[2], o[3]); *(u32x2*)(op + 16 * db) = w; }
                if (g == 0) lse[((size_t)(cur.br - 1) * T_TOK + qtok) * 8 + h] = lse0;
            } else {
                const float lm = fmaxf(lse0, fmaxf(l1, l2));
                const float w0 = __builtin_amdgcn_exp2f(lse0 - lm), w1 = __builtin_amdgcn_exp2f(l1 - lm), w2 = __builtin_amdgcn_exp2f(l2 - lm);
                const float wi = 1.0f / (w0 + w1 + w2), a0 = w0 * wi * inv, a1 = w1 * wi, a2 = w2 * wi;
                float ss = 0.f;
#pragma unroll
                for (int db = 0; db < 8; ++db) {
                    f32x4 o = oacc[db] * a0;
                    o[0] += bflo(x1[db].x) * a1 + bflo(x2[db].x) * a2; o[1] += bfhi(x1[db].x) * a1 + bfhi(x2[db].x) * a2;
                    o[2] += bflo(x1[db].y) * a1 + bflo(x2[db].y) * a2; o[3] += bfhi(x1[db].y) * a1 + bfhi(x2[db].y) * a2;
                    oacc[db] = o; ss += (o[0] * o[0] + o[1] * o[1]) + (o[2] * o[2] + o[3] * o[3]);
                }
                ss += __shfl_xor(ss, 16); ss += __shfl_xor(ss, 32);
                const float rs = rsqrtf(ss * (1.0f / 128.0f) + 1e-6f);
                f32x4 ggv[8];
#pragma unroll
                for (int db = 0; db < 8; ++db) ggv[db] = *(const f32x4*)(gain + h * 128 + 16 * db + 4 * g);
#pragma unroll
                for (int db = 0; db < 8; ++db) {
                    const f32x4 gg = ggv[db];
                    const f32x4 o = oacc[db] * rs * gg;
                    u32x2 w; w.x = cvt_pk_bf16(o[0], o[1]); w.y = cvt_pk_bf16(o[2], o[3]);
                    *(u32x2*)(mixed + pg8::tiled_off((int)qtok, h * 128 + 16 * db + 4 * g, DM / 64)) = w;
                }
            }
            asm volatile("s_waitcnt lgkmcnt(0)" ::: "memory"); __builtin_amdgcn_s_barrier(); asm volatile("" ::: "memory");
            cur = nxt;
        }
    }
#undef ATTN_LOAD_BLK
#undef ATTN_STORE_BLK
#undef ATTN_LOAD_Q
}

__device__ __forceinline__ void conv_phase(const Params& p, int l) {
    const bf16_t* proj = (const bf16_t*)(p.ws + WS_PROJ);
    bf16_t* mixed = (bf16_t*)(p.ws + WS_U);
    const float* gain = p.mix_g + (size_t)l * DM; const float* cw = p.conv_w + (size_t)l * 3 * 1024;
    const int tid = opaque_tid(), wid = tid >> 6, lane = tid & 63;
    u32x2 ngb[4], ngc0[4], nhi0[4], ngc1[4], nhi1[4], ngc2[4], nhi2[4];
#define CONV_LOAD(T) do { const int pos_ = (T) & (SEQ - 1); _Pragma("unroll") for (int i = 0; i < 4; ++i) { \
            const bf16_t* pr = proj + (size_t)(T) * DIN + i * 256 + lane * 4; \
            ngb[i] = *(const u32x2*)(pr + 3072); ngc0[i] = *(const u32x2*)(pr + 4096); nhi0[i] = *(const u32x2*)(pr + 5120); \
            ngc1[i] = (u32x2){0u, 0u}; nhi1[i] = ngc1[i]; ngc2[i] = ngc1[i]; nhi2[i] = ngc1[i]; \
            if (pos_ >= 1) { ngc1[i] = *(const u32x2*)(pr - DIN + 4096); nhi1[i] = *(const u32x2*)(pr - DIN + 5120); } \
            if (pos_ >= 2) { ngc2[i] = *(const u32x2*)(pr - 2 * DIN + 4096); nhi2[i] = *(const u32x2*)(pr - 2 * DIN + 5120); } } } while (0)
    int t = blockIdx.x * 8 + wid;
    if (t < T_TOK) CONV_LOAD(t);
    for (; t < T_TOK; t += gridDim.x * 8) {
        u32x2 gb[4], gc0[4], hi0[4], gc1[4], hi1[4], gc2[4], hi2[4];
#pragma unroll
        for (int i = 0; i < 4; ++i) { gb[i] = ngb[i]; gc0[i] = ngc0[i]; hi0[i] = nhi0[i]; gc1[i] = ngc1[i]; hi1[i] = nhi1[i]; gc2[i] = ngc2[i]; hi2[i] = nhi2[i]; }
        { const int tn = t + gridDim.x * 8; if (tn < T_TOK) CONV_LOAD(tn); }
        f32x4 cw0[4], cw1[4], cw2[4], g2[4];
#pragma unroll
        for (int i = 0; i < 4; ++i) { const int col = i * 256 + lane * 4;
            cw0[i] = *(const f32x4*)(cw + col); cw1[i] = *(const f32x4*)(cw + 1024 + col); cw2[i] = *(const f32x4*)(cw + 2048 + col); g2[i] = *(const f32x4*)(gain + 1024 + col); }
#pragma unroll
        for (int i = 0; i < 4; ++i) {
            const int col = i * 256 + lane * 4;
            f32x4 c0, c1, c2, gbv;
            c0[0] = bflo(gc0[i].x) * bflo(hi0[i].x); c0[1] = bfhi(gc0[i].x) * bfhi(hi0[i].x); c0[2] = bflo(gc0[i].y) * bflo(hi0[i].y); c0[3] = bfhi(gc0[i].y) * bfhi(hi0[i].y);
            c1[0] = bflo(gc1[i].x) * bflo(hi1[i].x); c1[1] = bfhi(gc1[i].x) * bfhi(hi1[i].x); c1[2] = bflo(gc1[i].y) * bflo(hi1[i].y); c1[3] = bfhi(gc1[i].y) * bfhi(hi1[i].y);
            c2[0] = bflo(gc2[i].x) * bflo(hi2[i].x); c2[1] = bfhi(gc2[i].x) * bfhi(hi2[i].x); c2[2] = bflo(gc2[i].y) * bflo(hi2[i].y); c2[3] = bfhi(gc2[i].y) * bfhi(hi2[i].y);
            gbv[0] = bflo(gb[i].x); gbv[1] = bfhi(gb[i].x); gbv[2] = bflo(gb[i].y); gbv[3] = bfhi(gb[i].y);
            f32x4 y = gbv * (cw0[i] * c2 + cw1[i] * c1 + cw2[i] * c0);
            float s2 = (y[0] * y[0] + y[1] * y[1]) + (y[2] * y[2] + y[3] * y[3]);
#pragma unroll
            for (int sft = 16; sft >= 1; sft >>= 1) s2 += __shfl_xor(s2, sft);
            const float rs2 = rsqrtf(s2 * (1.0f / 128.0f) + 1e-6f);
            y = y * rs2 * g2[i];
            u32x2 wy; wy.x = cvt_pk_bf16(y[0], y[1]); wy.y = cvt_pk_bf16(y[2], y[3]);
            *(u32x2*)(mixed + pg8::tiled_off(t, 1024 + col, DM / 64)) = wy;
        }
    }
#undef CONV_LOAD
}

#define XB_TMO      128
#define XB_XCNT(j)  (256  + 64 * (j))
#define XB_XSUB(j)  (1280 + 64 * (j))
#define XB_XGEN(j)  (2304 + 64 * (j))
#define XB_TOP      3328
#define XB_TOPGEN   3392
#define XB_LSUB(j)  (3456 + 64 * (j))
#define XB_LGEN(j)  (3968 + 64 * (j))
#define XCD_BAR_WORDS 4480
#define XB_SPIN_CAP (1u << 22)
__device__ __forceinline__ unsigned xb_ld(unsigned* p)              { return __hip_atomic_load(p, __ATOMIC_RELAXED, __HIP_MEMORY_SCOPE_AGENT); }
__device__ __forceinline__ unsigned xb_add(unsigned* p, unsigned v) { return __hip_atomic_fetch_add(p, v, __ATOMIC_RELAXED, __HIP_MEMORY_SCOPE_AGENT); }
#define XB_SPIN(cond, bar) do { unsigned _sp = 0; while (cond) { __builtin_amdgcn_s_sleep(1); \
    if ((++_sp & 255u) == 0u) { if (xb_ld(&(bar)[XB_TMO])) break; if (_sp > XB_SPIN_CAP) { atomicAdd(&(bar)[XB_TMO], 1u); break; } } } } while (0)
struct XcdBarrier { unsigned* bar; unsigned x; volatile LAS unsigned* st; };
__device__ __forceinline__ void xcd_barrier_complete(unsigned* bar, unsigned x, unsigned& nloc, unsigned& nx) {
    const unsigned G = gridDim.x * gridDim.y * gridDim.z;
    unsigned sum, cnt, mine, sp = 0u;
    for (;;) {
        sum = 0u; cnt = 0u; mine = 0u;
#pragma unroll
        for (unsigned j = 0; j < 16; ++j) { const unsigned c = xb_ld(&bar[XB_XCNT(j)]); sum += c; cnt += (c > 0u) ? 1u : 0u; mine = (j == x) ? c : mine; }
        if (sum == G) break;
        __builtin_amdgcn_s_sleep(1);
        if ((++sp & 255u) == 0u) { if (xb_ld(&bar[XB_TMO])) break; if (sp > XB_SPIN_CAP) { atomicAdd(&bar[XB_TMO], 1u); break; } }
    }
    nloc = mine > 0u ? mine : 1u; nx = cnt > 0u ? cnt : 1u;
}
__device__ __forceinline__ void xcd_barrier(const XcdBarrier& b) {
    asm volatile("s_waitcnt vmcnt(0)" ::: "memory");
    __syncthreads();
    if (threadIdx.x == 0) {
        unsigned* bar = b.bar;
        __builtin_amdgcn_s_waitcnt(0);
        unsigned nloc = b.st[0], nx = b.st[1];
        if (nloc == 0u) { xcd_barrier_complete(bar, b.x, nloc, nx); b.st[0] = nloc; b.st[1] = nx; }
        const unsigned old = xb_add(&bar[XB_XSUB(b.x)], 1u);
        const unsigned gen = old / nloc;
        if (old + 1u == (gen + 1u) * nloc) {
            __builtin_amdgcn_fence(__ATOMIC_RELEASE, "agent");
            asm volatile("s_waitcnt vmcnt(0)" ::: "memory");
            const unsigned og = xb_add(&bar[XB_TOP], 1u);
            const unsigned tg = og / nx;
            if (og + 1u == (tg + 1u) * nx) xb_add(&bar[XB_TOPGEN], 1u);
            else XB_SPIN(xb_ld(&bar[XB_TOPGEN]) == tg, bar);
            __builtin_amdgcn_fence(__ATOMIC_ACQUIRE, "agent");
            xb_add(&bar[XB_XGEN(b.x)], 1u);
            asm volatile("s_waitcnt vmcnt(0)" ::: "memory");
        } else {
            XB_SPIN(xb_ld(&bar[XB_XGEN(b.x)]) == gen, bar);
            __builtin_amdgcn_fence(__ATOMIC_ACQUIRE, "agent");
            asm volatile("s_waitcnt vmcnt(0)" ::: "memory");
        }
    }
    __syncthreads();
}

__device__ __forceinline__ void xcd_local_barrier(const XcdBarrier& b, unsigned nloc) {
    asm volatile("s_waitcnt vmcnt(0)" ::: "memory");
    __syncthreads();
    if (threadIdx.x == 0) {
        unsigned* bar = b.bar;
        __builtin_amdgcn_s_waitcnt(0);
        const unsigned old = xb_add(&bar[XB_LSUB(b.x)], 1u);
        const unsigned gen = old / nloc;
        if (old + 1u == (gen + 1u) * nloc) xb_add(&bar[XB_LGEN(b.x)], 1u);
        else XB_SPIN(xb_ld(&bar[XB_LGEN(b.x)]) == gen, bar);
        __builtin_amdgcn_fence(__ATOMIC_ACQUIRE, "agent");
        asm volatile("s_waitcnt vmcnt(0)" ::: "memory");
    }
    __syncthreads();
}

__global__ void __launch_bounds__(512, 2) fwd_megakernel(Params p) {
    extern __shared__ __attribute__((aligned(16))) unsigned char shm[];
    LAS unsigned char* lds = (LAS unsigned char*)shm;
    const float* mod = (const float*)(p.ws + WS_MOD);
    bf16_t* zb = (bf16_t*)(p.ws + WS_ZB);
    int vc = blockIdx.x, myrank = 0; bool xlocal = false;
    unsigned* bar = (unsigned*)(p.ws + WS_CTL);
    XcdBarrier xb; xb.bar = bar; xb.x = (unsigned)__builtin_amdgcn_s_getreg((3 << 11) | 20) & 0xFu; xb.st = (volatile LAS unsigned*)(lds + LDS_ST);
    const bool fused = (p.ph_hi - p.ph_lo) > 1;
    if (p.never) cg::this_grid().sync();
    if (fused) {
        if (threadIdx.x == 0) { xb.st[0] = 0u; xb.st[1] = 0u; xb.st[2] = xb_add(&bar[XB_XCNT(xb.x)], 1u); }
        __syncthreads();
        myrank = (int)xb.st[2];
    }
    for (int ph = p.ph_lo; ph < p.ph_hi; ++ph) {
        if (ph > p.ph_lo) {
            const int sb = (ph - 2) & 7;
            if (ph >= 2 && xlocal && sb >= 4) xcd_local_barrier(xb, gridDim.x / 8); else xcd_barrier(xb);
        }
        if (ph == 1 && fused) {
            unsigned cc[16];
#pragma unroll
            for (int i = 0; i < 16; ++i) cc[i] = xb_ld(&bar[XB_XCNT(i)]);
            unsigned bad = gridDim.x & 7u;
#pragma unroll
            for (int i = 0; i < 16; ++i) bad |= cc[i] ^ (i < 8 ? gridDim.x / 8 : 0u);
            if (bad == 0u) { vc = myrank * 8 + (int)xb.x; xlocal = gridDim.x == 256; }
        }
        if (ph == 0) { pro_a_phase(p, lds); continue; }
        if (ph == 1) { row_phase<false>(p.x, zb, nullptr, nullptr, nullptr, mod, 1 * DM, 0, (bf16_t*)(p.ws + WS_U), nullptr, -1); continue; }
        const int l = (ph - 2) >> 3, s = (ph - 2) & 7;
        const float* modl = mod + (size_t)l * 4 * 6 * DM;
        float* stats = (float*)(p.ws + WS_STATS);
        const int rown = gridDim.x == 256 ? (vc & 7) * 2048 + (vc >> 3) * 64 : -1;
        pg8::StaticOrder S;
        if (s == 0) {
            pg8::Gemm g{(const bf16_t*)(p.ws + WS_U), (const bf16_t*)(p.ws + WS_WT_IN) + (size_t)l * DIN * LDU, T_TOK, DIN, DM, LDU, LDU};
            S.init(g.M, g.N, gridDim.x, vc, 4);
            pg8::EpiProj E{(bf16_t*)(p.ws + WS_PROJ), (const float*)(p.ws + WS_COS), (const float*)(p.ws + WS_SIN)};
            pg8::gemm_phase<pg8::EpiProj>(lds, g, S, E);
        } else if (s == 1) {
            attn_phase(p, lds, l, 0); conv_phase(p, l);
        } else if (s == 2) {
            attn_phase(p, lds, l, 1);
        } else if (s == 3 || s == 6) {
            pg8::Gemm g; pg8::EpiRes E;
            if (s == 3) { g = pg8::Gemm{(const bf16_t*)(p.ws + WS_U), (const bf16_t*)(p.ws + WS_WT_OUT) + (size_t)l * DM * LDU, T_TOK, DM, DM, LDU, LDU};
                          E = pg8::EpiRes{zb, modl + 2 * DM, l == 0 ? nullptr : stats, p.ln2_g + (size_t)(l - (l > 0)) * DM, p.ln2_b + (size_t)(l - (l > 0)) * DM}; }
            else        { g = pg8::Gemm{(const bf16_t*)(p.ws + WS_H), (const bf16_t*)(p.ws + WS_WT_FF2) + (size_t)l * DM * LDH, T_TOK, DM, DFF, LDH, LDH};
                          E = pg8::EpiRes{zb, modl + 5 * DM, stats, p.ln1_g + (size_t)l * DM, p.ln1_b + (size_t)l * DM}; }
            S.init(g.M, g.N, gridDim.x, vc, 4);
            pg8::gemm_phase<pg8::EpiRes>(lds, g, S, E);
        } else if (s == 4 || s == 7) {
            if (s == 4) row_phase<true>(nullptr, zb, p.out, p.ln1_g + (size_t)l * DM, p.ln1_b + (size_t)l * DM, modl, 4 * DM, 3 * DM, (bf16_t*)(p.ws + WS_U), stats, rown);
            else        row_phase<true>(nullptr, zb, p.out, p.ln2_g + (size_t)l * DM, p.ln2_b + (size_t)l * DM, modl + (size_t)4 * 6 * DM, 1 * DM, 0, (l + 1 < NLAYER) ? (bf16_t*)(p.ws + WS_U) : nullptr, (l + 1 < NLAYER) ? stats : nullptr, rown);
        } else {
            pg8::Gemm g{(const bf16_t*)(p.ws + WS_U), (const bf16_t*)(p.ws + WS_WT_FF1) + (size_t)l * DFF * LDU, T_TOK, DFF, DM, LDU, LDU};
            S.init(g.M, g.N, gridDim.x, vc, 4);
            pg8::EpiFF1 E{(bf16_t*)(p.ws + WS_H)};
            pg8::gemm_phase<pg8::EpiFF1>(lds, g, S, E);
        }
    }
}

constexpr int N_PHASES = 2 + 8 * NLAYER;

extern "C" void kernel_launch(void* const* d_in, const int* in_sizes, int n_in, void* d_out, int out_size, void* d_ws, size_t ws_size, hipStream_t stream) {
    static int grid = 0;
    if (grid == 0) {
        int dev = 0, cus = 0, per_cu = 0;
        (void)hipGetDevice(&dev);
        (void)hipDeviceGetAttribute(&cus, hipDeviceAttributeMultiprocessorCount, dev);
        if (hipFuncSetAttribute((const void*)fwd_megakernel, hipFuncAttributeMaxDynamicSharedMemorySize, LDS_BYTES) != hipSuccess) fprintf(stderr, "hipFuncSetAttribute failed\n");
        if (hipOccupancyMaxActiveBlocksPerMultiprocessor(&per_cu, (const void*)fwd_megakernel, 512, LDS_BYTES) != hipSuccess || per_cu < 1) per_cu = 1;
        (void)hipGetLastError();
        grid = cus * per_cu;
        if (ws_size < WS_END) fprintf(stderr, "workspace too small: %zu < %zu\n", ws_size, (size_t)WS_END);
    }
    Params p{};
    p.x = (const float*)d_in[0]; p.c = (const float*)d_in[1]; p.w_in = (const float*)d_in[2]; p.conv_w = (const float*)d_in[3]; p.mix_g = (const float*)d_in[4];
    p.w_out = (const float*)d_in[5]; p.w_mod = (const float*)d_in[6]; p.b_mod = (const float*)d_in[7]; p.ln1_g = (const float*)d_in[8]; p.ln1_b = (const float*)d_in[9];
    p.w_ff1 = (const float*)d_in[10]; p.w_ff2 = (const float*)d_in[11]; p.ln2_g = (const float*)d_in[12]; p.ln2_b = (const float*)d_in[13];
    p.out = (float*)d_out; p.ws = (unsigned char*)d_ws;
#if SINGLE_LAUNCH
    (void)hipMemsetAsync((unsigned char*)d_ws + WS_CTL, 0, 20480, stream);
    p.ph_lo = 0; p.ph_hi = N_PHASES;
    void* args[] = {&p};
    hipError_t e = hipLaunchCooperativeKernel((const void*)fwd_megakernel, dim3(grid), dim3(512), args, LDS_BYTES, stream);
    if (e != hipSuccess) fprintf(stderr, "cooperative launch failed: %s (grid %d)\n", hipGetErrorString(e), grid);
#else
    for (int ph = 0; ph < N_PHASES; ++ph) {
        p.ph_lo = ph; p.ph_hi = ph + 1;
        hipLaunchKernelGGL(fwd_megakernel, dim3(grid), dim3(512), LDS_BYTES, stream, p);
    }
#endif
}
```
